# Optimizing an MI355X kernel written in HIP

```python
import math
import jax
import jax.numpy as jnp
from jax import lax
import numpy as np

D_MODEL = 1024
BATCH = 2
SEQ = 8192
DEPTH = 2

HEAD_DIM = 64
BRANCH_WIDTH = 256
N_BRANCH = 4
SB_HEADS = 4
Q_BLOCK = 128
S5_GROUPS = 16
S5_GROUP_CH = 16
S5_STATE = 64
S5_WIDTH = S5_GROUPS * S5_GROUP_CH
GLA_HEADS = 4
GLA_DK = 32
GLA_DV = 64
GLA_GATE_RANK = 16
GLA_GATE_NORM = 16.0
GLA_CHUNK = 64
DSA_HEADS = 4
DSA_PATTERNS = ((128, 1), (512, 4), (2048, 16))
DSA_BLOCK = 128
ROPE_THETA = 10000.0
D_FF = 2816
RMS_EPS = 1e-6
IN_SPLITS = (
    3 * SB_HEADS * HEAD_DIM,
    S5_WIDTH,
    GLA_HEADS * GLA_DK,
    GLA_HEADS * GLA_DK,
    GLA_HEADS * GLA_DV,
    GLA_HEADS * GLA_DV,
    GLA_GATE_RANK,
    3 * DSA_HEADS * HEAD_DIM,
    N_BRANCH * D_MODEL,
)
IN_WIDTH = sum(IN_SPLITS)

kernel_name = "hybrid_gated_four_mixer_macaron"


def rms_norm(x, g):
    x32 = x.astype(jnp.float32)
    y = x32 * lax.rsqrt(jnp.mean(x32 * x32, axis=-1, keepdims=True) + RMS_EPS)
    return (y * g.astype(jnp.float32)).astype(x.dtype)


def swiglu(x, w_in, w_out):
    a, b = jnp.split(x @ w_in, 2, axis=-1)
    return (jax.nn.silu(a) * b) @ w_out


def rope_tables(seq):
    inv = ROPE_THETA ** (-jnp.arange(0, HEAD_DIM, 2, dtype=jnp.float32) / HEAD_DIM)
    ang = jnp.arange(seq, dtype=jnp.float32)[:, None] * inv[None, :]
    return jnp.cos(ang), jnp.sin(ang)


def apply_rope(x, cos, sin):
    half = x.shape[-1] // 2
    x1, x2 = x[..., :half], x[..., half:]
    c, s = cos[None, :, None, :], sin[None, :, None, :]
    return jnp.concatenate([x1 * c - x2 * s, x2 * c + x1 * s], axis=-1)


def stick_breaking_attention(q, k, v):
    bsz, seq, heads, hd = q.shape
    nb = seq // Q_BLOCK
    qf = q.astype(jnp.float32) * (hd ** -0.5)
    kf = k.astype(jnp.float32)
    vf = v.astype(jnp.float32)
    q_blocks = qf.reshape(bsz, nb, Q_BLOCK, heads, hd).transpose(1, 0, 3, 2, 4)
    key_pos = jnp.arange(seq)

    def one_block(args):
        qb, blk = args
        z = jnp.einsum('bhqd,bshd->bhqs', qb, kf)
        q_pos = blk * Q_BLOCK + jnp.arange(Q_BLOCK)
        strict = key_pos[None, :] < q_pos[:, None]
        log_keep = jnp.where(strict, jax.nn.log_sigmoid(-z), 0.0)
        log_after = lax.cumsum(log_keep, axis=3, reverse=True) - log_keep
        w = jnp.where(strict, jnp.exp(jax.nn.log_sigmoid(z) + log_after), 0.0)
        return jnp.einsum('bhqs,bshd->bqhd', w, vf)

    out = lax.map(one_block, (q_blocks, jnp.arange(nb)))
    return out.transpose(1, 0, 2, 3, 4).reshape(bsz, seq, heads * hd)


def s5_mixer(u, lam_re, lam_im, log_step, b_re, b_im, c_re, c_im, d_skip, w_glu):
    bsz, seq, _ = u.shape
    uf = u.astype(jnp.float32).reshape(bsz, seq, S5_GROUPS, S5_GROUP_CH)
    lam = lax.complex(lam_re.astype(jnp.float32), lam_im.astype(jnp.float32))
    dt = jnp.exp(log_step.astype(jnp.float32))[:, None]
    lam_bar = jnp.exp(lam * dt)
    b_mat = lax.complex(b_re.astype(jnp.float32), b_im.astype(jnp.float32))
    b_bar = ((lam_bar - 1.0) / lam)[..., None] * b_mat
    c_mat = lax.complex(c_re.astype(jnp.float32), c_im.astype(jnp.float32))
    bu = jnp.einsum('bsgh,gph->bsgp', uf.astype(jnp.complex64), b_bar)
    a = jnp.broadcast_to(lam_bar, bu.shape)

    def combine(e1, e2):
        a1, b1 = e1
        a2, b2 = e2
        return a1 * a2, a2 * b1 + b2

    _, states = lax.associative_scan(combine, (a, bu), axis=1)
    y = jnp.einsum('bsgp,ghp->bsgh', states, c_mat).real + d_skip.astype(jnp.float32) * uf
    y = jax.nn.gelu(y.reshape(bsz, seq, S5_WIDTH))
    ga, gb = jnp.split(y @ w_glu.astype(jnp.float32), 2, axis=-1)
    return ga * jax.nn.sigmoid(gb)


def gla_mixer(q, k, v, r, g1, w_gate, b_gate, norm_g):
    bsz, seq, _ = q.shape
    nc = seq // GLA_CHUNK
    z = g1.astype(jnp.float32) @ w_gate.astype(jnp.float32) + b_gate.astype(jnp.float32)
    log_a = jax.nn.log_sigmoid(z) / GLA_GATE_NORM

    def heads(t, dh):
        t = t.astype(jnp.float32).reshape(bsz, nc, GLA_CHUNK, GLA_HEADS, dh)
        return t.transpose(1, 0, 3, 2, 4)

    qc = heads(q, GLA_DK) * (GLA_DK ** -0.5)
    kc = heads(k, GLA_DK)
    vc = heads(v, GLA_DV)
    gc = heads(log_a, GLA_DK)
    causal = jnp.tril(jnp.ones((GLA_CHUNK, GLA_CHUNK), dtype=bool))

    def step(state, inp):
        qi, ki, vi, gi = inp
        bcum = jnp.cumsum(gi, axis=2)
        o_inter = jnp.einsum('bhcd,bhde->bhce', qi * jnp.exp(bcum), state)
        diff = bcum[:, :, :, None, :] - bcum[:, :, None, :, :]
        decay = jnp.exp(jnp.where(causal[:, :, None], diff, -jnp.inf))
        att = jnp.einsum('bhid,bhjd,bhijd->bhij', qi, ki, decay)
        o = o_inter + jnp.einsum('bhij,bhje->bhie', att, vi)
        blast = bcum[:, :, -1:, :]
        state = jnp.exp(blast[:, :, 0, :])[..., None] * state + jnp.einsum(
            'bhcd,bhce->bhde', ki * jnp.exp(blast - bcum), vi)
        return state, o

    s0 = jnp.zeros((bsz, GLA_HEADS, GLA_DK, GLA_DV), jnp.float32)
    _, o = lax.scan(step, s0, (qc, kc, vc, gc))
    o = o.transpose(1, 0, 3, 2, 4).reshape(bsz, seq, GLA_HEADS, GLA_DV)
    o = rms_norm(o, norm_g.reshape(GLA_HEADS, GLA_DV))
    return o.reshape(bsz, seq, GLA_HEADS * GLA_DV) * jax.nn.silu(r.astype(jnp.float32))


def to_residue(t, dil, padded):
    bsz, seq, heads, hd = t.shape
    t = jnp.pad(t, ((0, 0), (0, padded - seq), (0, 0), (0, 0)))
    t = t.reshape(bsz, padded // dil, dil, heads, hd).transpose(0, 2, 3, 1, 4)
    return t.reshape(bsz * dil * heads, padded // dil, hd)


def from_residue(t, bsz, dil, heads, seq):
    rest = t.shape[2:]
    length = t.shape[1]
    t = jnp.moveaxis(t.reshape((bsz, dil, heads, length) + rest), 3, 1)
    return t.reshape((bsz, length * dil, heads) + rest)[:, :seq]


def banded_window_attention(q, k, v, n_steps):
    rows, length, hd = q.shape
    nb = length // DSA_BLOCK
    qb = q.reshape(rows, nb, DSA_BLOCK, hd)

    def key_blocks(t):
        tp = jnp.pad(t, ((0, 0), (DSA_BLOCK, 0), (0, 0)))
        prev = tp[:, :length].reshape(rows, nb, DSA_BLOCK, hd)
        cur = tp[:, DSA_BLOCK:].reshape(rows, nb, DSA_BLOCK, hd)
        return jnp.concatenate([prev, cur], axis=2)

    kb, vb = key_blocks(k), key_blocks(v)
    s = jnp.einsum('nbqd,nbkd->nbqk', qb, kb) * (hd ** -0.5)
    qi = jnp.arange(DSA_BLOCK)[:, None]
    kj = jnp.arange(2 * DSA_BLOCK)[None, :]
    dist = qi + DSA_BLOCK - kj
    key_idx = jnp.arange(nb)[:, None, None] * DSA_BLOCK + kj[None] - DSA_BLOCK
    valid = ((dist >= 0) & (dist <= n_steps))[None] & (key_idx >= 0)
    s = jnp.where(valid, s, -jnp.inf)
    lse = jax.nn.logsumexp(s, axis=-1)
    p = jnp.exp(s - lse[..., None])
    o = jnp.einsum('nbqk,nbkd->nbqd', p, vb)
    return o.reshape(rows, length, hd), lse.reshape(rows, length)


def dilated_mixer(q, k, v, q_norm, k_norm, cos, sin):
    bsz, seq, heads, hd = q.shape
    qf = apply_rope(rms_norm(q.astype(jnp.float32), q_norm), cos, sin)
    kf = apply_rope(rms_norm(k.astype(jnp.float32), k_norm), cos, sin)
    vf = v.astype(jnp.float32)
    outs, lses = [], []
    for window, dil in DSA_PATTERNS:
        span = dil * DSA_BLOCK
        padded = -(-seq // span) * span
        o, lse = banded_window_attention(to_residue(qf, dil, padded), to_residue(kf, dil, padded),
                                         to_residue(vf, dil, padded), window // dil)
        outs.append(from_residue(o, bsz, dil, heads, seq))
        lses.append(from_residue(lse, bsz, dil, heads, seq))
    w = jax.nn.softmax(jnp.stack(lses, axis=0), axis=0)
    out = jnp.sum(w[..., None] * jnp.stack(outs, axis=0), axis=0)
    return out.reshape(bsz, seq, heads * hd)


def hybrid_layer(x, cos, sin, ffn1_norm, ffn1_w_in, ffn1_w_out, mix_norm, w_in,
                 s5_lam_re, s5_lam_im, s5_log_step, s5_b_re, s5_b_im, s5_c_re, s5_c_im, s5_d, s5_w_glu,
                 gla_w_gate, gla_b_gate, gla_norm, dsa_q_norm, dsa_k_norm, w_branch, w_out,
                 ffn2_norm, ffn2_w_in, ffn2_w_out):
    bsz, seq, _ = x.shape
    h = x + 0.5 * swiglu(rms_norm(x, ffn1_norm), ffn1_w_in, ffn1_w_out)
    u = rms_norm(h, mix_norm)
    proj = u @ w_in
    (sb_qkv, s5_u, gq, gk, gv, gr, gg, dsa_qkv, gates) = jnp.split(
        proj, np.cumsum(IN_SPLITS)[:-1].tolist(), axis=-1)

    sb_q, sb_k, sb_v = [t.reshape(bsz, seq, SB_HEADS, HEAD_DIM) for t in jnp.split(sb_qkv, 3, axis=-1)]
    y_sb = stick_breaking_attention(sb_q, sb_k, sb_v)
    y_s5 = s5_mixer(s5_u, s5_lam_re, s5_lam_im, s5_log_step, s5_b_re, s5_b_im, s5_c_re, s5_c_im,
                    s5_d, s5_w_glu)
    y_gla = gla_mixer(gq, gk, gv, gr, gg, gla_w_gate, gla_b_gate, gla_norm)
    d_q, d_k, d_v = [t.reshape(bsz, seq, DSA_HEADS, HEAD_DIM) for t in jnp.split(dsa_qkv, 3, axis=-1)]
    y_dsa = dilated_mixer(d_q, d_k, d_v, dsa_q_norm, dsa_k_norm, cos, sin)

    branches = jnp.stack([y_sb, y_s5, y_gla, y_dsa], axis=2).astype(x.dtype)
    gate = jax.nn.sigmoid(gates.reshape(bsz, seq, N_BRANCH, D_MODEL))
    per_branch = jnp.einsum('bsnw,nwd->bsnd', branches, w_branch)
    mixed = jnp.sum(gate * per_branch, axis=2)
    h = h + mixed @ w_out
    return h + 0.5 * swiglu(rms_norm(h, ffn2_norm), ffn2_w_in, ffn2_w_out)


def setup_inputs(seed: int = 0) -> dict:
    key = jax.random.key(seed)
    ks = jax.random.split(key, 26)
    f32 = jnp.float32
    L = DEPTH
    G, P, H = S5_GROUPS, S5_STATE, S5_GROUP_CH

    def normal(k, shape, scale):
        return jax.random.normal(k, shape, f32) * scale

    def gain(k, n):
        return 1.0 + 0.02 * jax.random.normal(k, (L, n), f32)

    return {
        'x': normal(ks[0], (BATCH, SEQ, D_MODEL), 1.0),
        'ffn1_norm': gain(ks[1], D_MODEL),
        'ffn1_w_in': normal(ks[2], (L, D_MODEL, 2 * D_FF), D_MODEL ** -0.5),
        'ffn1_w_out': normal(ks[3], (L, D_FF, D_MODEL), D_FF ** -0.5),
        'mix_norm': gain(ks[4], D_MODEL),
        'w_in': normal(ks[5], (L, D_MODEL, IN_WIDTH), D_MODEL ** -0.5),
        's5_lam_re': -0.5 + normal(ks[6], (L, G, P), 0.01),
        's5_lam_im': jnp.pi * jnp.arange(P, dtype=f32) + normal(ks[7], (L, G, P), 0.01),
        's5_log_step': jax.random.uniform(ks[8], (L, G), f32, math.log(1e-3), math.log(1e-1)),
        's5_b_re': normal(ks[9], (L, G, P, H), (2 * H) ** -0.5),
        's5_b_im': normal(ks[10], (L, G, P, H), (2 * H) ** -0.5),
        's5_c_re': normal(ks[11], (L, G, H, P), P ** -0.5),
        's5_c_im': normal(ks[12], (L, G, H, P), P ** -0.5),
        's5_d': normal(ks[13], (L, G, H), 1.0),
        's5_w_glu': normal(ks[14], (L, S5_WIDTH, 2 * S5_WIDTH), S5_WIDTH ** -0.5),
        'gla_w_gate': normal(ks[15], (L, GLA_GATE_RANK, GLA_HEADS * GLA_DK), GLA_GATE_RANK ** -0.5),
        'gla_b_gate': normal(ks[16], (L, GLA_HEADS * GLA_DK), 0.01),
        'gla_norm': gain(ks[17], GLA_HEADS * GLA_DV),
        'dsa_q_norm': gain(ks[18], HEAD_DIM),
        'dsa_k_norm': gain(ks[19], HEAD_DIM),
        'w_branch': normal(ks[20], (L, N_BRANCH, BRANCH_WIDTH, D_MODEL), BRANCH_WIDTH ** -0.5),
        'w_out': normal(ks[21], (L, D_MODEL, D_MODEL), D_MODEL ** -0.5),
        'ffn2_norm': gain(ks[22], D_MODEL),
        'ffn2_w_in': normal(ks[23], (L, D_MODEL, 2 * D_FF), D_MODEL ** -0.5),
        'ffn2_w_out': normal(ks[24], (L, D_FF, D_MODEL), D_FF ** -0.5),
    }


def reference(x, ffn1_norm, ffn1_w_in, ffn1_w_out, mix_norm, w_in, s5_lam_re, s5_lam_im, s5_log_step,
              s5_b_re, s5_b_im, s5_c_re, s5_c_im, s5_d, s5_w_glu, gla_w_gate, gla_b_gate, gla_norm,
              dsa_q_norm, dsa_k_norm, w_branch, w_out, ffn2_norm, ffn2_w_in, ffn2_w_out):
    cos, sin = rope_tables(x.shape[1])
    h = x
    for l in range(DEPTH):
        h = hybrid_layer(h, cos, sin, ffn1_norm[l], ffn1_w_in[l], ffn1_w_out[l], mix_norm[l], w_in[l],
                         s5_lam_re[l], s5_lam_im[l], s5_log_step[l], s5_b_re[l], s5_b_im[l],
                         s5_c_re[l], s5_c_im[l], s5_d[l], s5_w_glu[l], gla_w_gate[l], gla_b_gate[l],
                         gla_norm[l], dsa_q_norm[l], dsa_k_norm[l], w_branch[l], w_out[l],
                         ffn2_norm[l], ffn2_w_in[l], ffn2_w_out[l])
    return h
```

```cpp
#include <hip/hip_runtime.h>
#include <hip/hip_cooperative_groups.h>
#include <cstdio>
#include <cstdint>
namespace cg = cooperative_groups;

#define LAS __attribute__((address_space(3)))
typedef unsigned short bf16_t;
typedef short bf16x8 __attribute__((ext_vector_type(8)));
typedef float f32x4 __attribute__((ext_vector_type(4)));
typedef float f32x2 __attribute__((ext_vector_type(2)));
typedef unsigned u32x4 __attribute__((ext_vector_type(4)));
typedef unsigned u32x2 __attribute__((ext_vector_type(2)));

constexpr int T = 16384, DM = 1024, FF = 2816, SEQ = 8192;
constexpr int PP = 2816;
constexpr int C_SBQ = 0, C_SBK = 256, C_SBV = 512, C_S5U = 768, C_GQ = 1024, C_GK = 1152, C_GV = 1280, C_GR = 1536, C_GG = 1792,
              C_DQ = 1808, C_DK = 2064, C_DV = 2320, C_GATE = 2576, IN_W = 6672;
constexpr float EPS = 1e-6f;
constexpr int NTHR = 512, NWAVES = 8;
constexpr int LDS_BYTES = 135168;

constexpr size_t MiB = 1u << 20;
constexpr size_t WS_W1T = 0, WS_W2T = 11 * MiB, WS_WPT = 16 * MiB + 512 * 1024, WS_WGT = 22 * MiB, WS_WBT = 30 * MiB, WS_WOT = 32 * MiB,
                 WS_W3T = 34 * MiB, WS_W4T = 45 * MiB, WS_WGLUT = 50 * MiB + 512 * 1024;
constexpr size_t WS_HB = 51 * MiB;
constexpr size_t WS_MIX = WS_HB;
constexpr size_t WS_BR = 83 * MiB;
constexpr size_t WS_HB2 = WS_BR;
constexpr size_t WS_ACT = 115 * MiB;
constexpr size_t WS_G = WS_ACT;
constexpr size_t WS_TAIL = WS_ACT + 88 * MiB;
constexpr size_t WS_YS5 = WS_TAIL;
constexpr size_t WS_GSL = WS_YS5 + 8 * MiB;
constexpr size_t WS_GSI = WS_GSL + 8 * MiB;
constexpr size_t WS_S5E = WS_GSI + 8 * MiB;
constexpr size_t WS_S5C = WS_S5E + 2 * MiB;
constexpr size_t WS_MISC = 243 * MiB;
constexpr size_t WS_ROWSQ = WS_MISC;
constexpr size_t WS_ROPE = WS_MISC + 512 * 1024;
constexpr size_t WS_S5P = WS_ROPE + 2 * MiB;
constexpr size_t WS_GBL = WS_S5P + 512 * 1024;
constexpr size_t WS_BARW = WS_GBL + 512 * 1024;
constexpr size_t WS_END = WS_GBL + 1 * MiB;

typedef __bf16 bf16x2_t __attribute__((ext_vector_type(2)));
__device__ __forceinline__ unsigned cvt_pk_bf16(float lo, float hi) { f32x2 v = {lo, hi}; bf16x2_t b = __builtin_convertvector(v, bf16x2_t); return __builtin_bit_cast(unsigned, b); }
__device__ __forceinline__ float bflo(unsigned u) { return __uint_as_float(u << 16); }
__device__ __forceinline__ float bfhi(unsigned u) { return __uint_as_float(u & 0xffff0000u); }
__device__ __forceinline__ float bf1(bf16_t h) { return __uint_as_float(((unsigned)h) << 16); }
__device__ __forceinline__ bf16_t f2bf(float f) { return (bf16_t)(cvt_pk_bf16(f, 0.f) & 0xffffu); }
__device__ __forceinline__ u32x4 pack8(f32x4 a, f32x4 b) { u32x4 w; w.x = cvt_pk_bf16(a[0], a[1]); w.y = cvt_pk_bf16(a[2], a[3]); w.z = cvt_pk_bf16(b[0], b[1]); w.w = cvt_pk_bf16(b[2], b[3]); return w; }
__device__ __forceinline__ void unpack8(u32x4 w, float* f) { f[0] = bflo(w.x); f[1] = bfhi(w.x); f[2] = bflo(w.y); f[3] = bfhi(w.y); f[4] = bflo(w.z); f[5] = bfhi(w.z); f[6] = bflo(w.w); f[7] = bfhi(w.w); }
__device__ __forceinline__ float sigmoidf_(float x) { return __builtin_amdgcn_rcpf(1.f + __expf(-x)); }
#define LDS_WAIT() asm volatile("s_waitcnt lgkmcnt(0)" ::: "memory")

namespace pg8 {
constexpr int BM = 256, BK = 64, HALF = 128, HTB = HALF * BK * 2, NXCD = 8, WGM = 8;
__host__ __device__ __forceinline__ int lds_byte(int r, int c) { const int st = (r >> 4) * 2 + (c >> 5), rr = r & 15, cc = c & 31, ob = rr * 64 + cc * 2; return st * 1024 + (ob ^ (((ob >> 9) & 1) << 5)); }
__host__ __device__ __forceinline__ void stage_rc(int b, int& R, int& C) { const int st = b / 1024, sb = b % 1024, swz = sb ^ (((sb >> 9) & 1) << 5); R = (st >> 1) * 16 + swz / 64; C = (st & 1) * 32 + (swz % 64) / 2; }
__host__ __device__ __forceinline__ int perm32(int rho) { const int n = rho >> 4, i = rho & 15; return 8 * (i >> 2) + 4 * n + (i & 3); }
struct Unit { int pm, pn, kind; };

__device__ __forceinline__ void tile_map(int L, int nM, int nN, int& pm, int& pn) {
    const int nwg = nM * nN; int wgid = L;
    { const int q = nwg / NXCD, r = nwg % NXCD, xcd = wgid % NXCD, off = wgid / NXCD; wgid = (xcd < r ? xcd * (q + 1) : r * (q + 1) + (xcd - r) * q) + off; }
    const int nig = WGM * nN, gid = wgid / nig, fm = gid * WGM, gsz = (nM - fm) < WGM ? (nM - fm) : WGM;
    pm = fm + ((wgid % nig) % gsz); pn = (wgid % nig) / gsz;
}
struct StdSched {
    const char* A; const char* Bt; size_t tsA, tsB; int ntk; int nM, nN, nwg, G, c;
    __device__ __forceinline__ void init(const void* A_, const void* Bt_, int M, int N, int K, int lda, int ldb, int G_, int c_) {
        A = (const char*)A_; Bt = (const char*)Bt_; tsA = (size_t)BM * lda * 2; tsB = (size_t)BM * ldb * 2; ntk = K / BK; nM = M / BM; nN = N / BM; nwg = nM * nN; G = G_; c = c_; }
    __device__ __forceinline__ bool next(int i, Unit& u) const { const long L = (long)i * G + c; if (L >= nwg) return false; tile_map((int)L, nM, nN, u.pm, u.pn); u.kind = 0; return true; }
    __device__ __forceinline__ const char* pa(const Unit& u) const { return A + (size_t)u.pm * tsA; }
    __device__ __forceinline__ const char* pb(const Unit& u) const { return Bt + (size_t)u.pn * tsB; }
    __device__ __forceinline__ int nt(const Unit&) const { return ntk; }
};
struct PbSched {
    const char* A; const char* Bt; int G, c;
    __device__ __forceinline__ void init(const void* A_, const void* Bt_, int G_, int c_) { A = (const char*)A_; Bt = (const char*)Bt_; G = G_; c = c_; }
    __device__ __forceinline__ bool next(int i, Unit& u) const { const long L = (long)(i >> 2) * G + c; if (L >= 256) return false; tile_map((int)L, 64, 4, u.pm, u.pn); u.kind = i & 3; return true; }
    __device__ __forceinline__ const char* pa(const Unit& u) const { return A + (size_t)u.pm * (256 * 1024 * 2) + u.kind * 512; }
    __device__ __forceinline__ const char* pb(const Unit& u) const { return Bt + (size_t)u.pn * (256 * 1024 * 2) + u.kind * 512; }
    __device__ __forceinline__ int nt(const Unit&) const { return 4; }
};

template <class Epi, class Sched>
__device__ __forceinline__ void gemm_phase(LAS unsigned char* lds, int lda, int ldb, const Sched& S, const Epi& E) {
    const int tid = threadIdx.x, wid = __builtin_amdgcn_readfirstlane(tid >> 6), lane = tid & 63, wr = wid >> 2, wc = wid & 3, fr = lane & 15, fq = lane >> 4;
    unsigned voffA[2], voffB[2];
#pragma unroll
    for (int i = 0; i < 2; ++i) { int R, C; stage_rc(tid * 16 + i * 8192, R, C); const int Rb = (R & ~31) + perm32(R & 31);
        voffA[i] = (unsigned)(R * lda + C) * 2u; voffB[i] = (unsigned)(Rb * ldb + C) * 2u; }
    const size_t kstep = (size_t)(BK * 2);
    const size_t hsA = (size_t)HALF * lda * 2, hsB = (size_t)HALF * ldb * 2;
    const unsigned ldsw = (unsigned)wid * 1024u;
    const int aoff = lds_byte(wr * 64 + fr, fq * 8), boff = lds_byte(wc * 32 + fr, fq * 8);
#define PG8_SA(b, h) (((b) * 2 + (h)) * HTB)
#define PG8_SB(b, h) ((4 + (b) * 2 + (h)) * HTB)
#define PG8_STAGE(bufoff, gbase, voff) do { _Pragma("unroll") for (int _i = 0; _i < 2; ++_i) \
        __builtin_amdgcn_global_load_lds((const unsigned*)((const char*)(gbase) + (voff)[_i]), (LAS unsigned*)(lds + (bufoff) + ldsw + _i * 8192), 16, 0, 0); } while (0)
#define PG8_LDA(dst, b, h) do { _Pragma("unroll") for (int m = 0; m < 4; ++m) _Pragma("unroll") for (int k = 0; k < 2; ++k) dst[m][k] = *(const LAS bf16x8*)(lds + PG8_SA(b, h) + aoff + m * 2048 + k * 1024); } while (0)
#define PG8_LDB(dst, b, h) do { _Pragma("unroll") for (int n = 0; n < 2; ++n) _Pragma("unroll") for (int k = 0; k < 2; ++k) dst[n][k] = *(const LAS bf16x8*)(lds + PG8_SB(b, h) + boff + n * 2048 + k * 1024); } while (0)
#define PG8_MMA(ai, bj, At, Bt) do { __builtin_amdgcn_s_setprio(1); _Pragma("unroll") for (int m = 0; m < 4; ++m) _Pragma("unroll") for (int n = 0; n < 2; ++n) _Pragma("unroll") for (int k = 0; k < 2; ++k) \
        acc[ai][bj][m][n] = __builtin_amdgcn_mfma_f32_16x16x32_bf16(Bt[n][k], At[m][k], acc[ai][bj][m][n], 0, 0, 0); __builtin_amdgcn_s_setprio(0); } while (0)
#define PG8_WAIT_V(n) asm volatile("s_waitcnt vmcnt(" #n ")" ::: "memory")
#define PG8_WAIT_L(n) asm volatile("s_waitcnt lgkmcnt(" #n ")" ::: "memory")
#define PG8_BAR __builtin_amdgcn_s_barrier()
#define PG8_SCHED __builtin_amdgcn_sched_barrier(0)
    Unit cur, nxt; int ui = 0;
    if (!S.next(0, cur)) return;
    f32x4 acc[2][2][4][2];
#pragma unroll
    for (int a = 0; a < 2; ++a)
#pragma unroll
        for (int b = 0; b < 2; ++b)
#pragma unroll
            for (int m = 0; m < 4; ++m)
#pragma unroll
                for (int n = 0; n < 2; ++n) acc[a][b][m][n] = (f32x4){0.f, 0.f, 0.f, 0.f};
    bf16x8 At[4][2], B0[2][2], B1[2][2];
    const char* cA = S.pa(cur); const char* cB = S.pb(cur);
    {
        PG8_STAGE(PG8_SB(0, 0), cB, voffB); PG8_STAGE(PG8_SB(0, 1), cB + hsB, voffB); PG8_STAGE(PG8_SA(0, 0), cA, voffA); PG8_STAGE(PG8_SA(0, 1), cA + hsA, voffA);
        if (wr == 1) PG8_BAR;
        PG8_WAIT_V(2); PG8_BAR;
        PG8_STAGE(PG8_SB(1, 0), cB + kstep, voffB); PG8_STAGE(PG8_SA(1, 0), cA + kstep, voffA); PG8_STAGE(PG8_SB(1, 1), cB + hsB + kstep, voffB);
        PG8_WAIT_V(6); PG8_BAR;
    }
    for (;;) {
        const bool has_next = S.next(ui + 1, nxt);
        const char* nA = has_next ? S.pa(nxt) : cA; const char* nB = has_next ? S.pb(nxt) : cB;
        const int nt = S.nt(cur);
        for (int t = 0; t < nt; t += 2) {
            const bool last = (t == nt - 2);
            const char* a1 = cA + (size_t)(t + 1) * kstep;
            const char* a2 = last ? nA : cA + (size_t)(t + 2) * kstep; const char* b2 = last ? nB : cB + (size_t)(t + 2) * kstep;
            const char* a3 = a2 + kstep; const char* b3 = b2 + kstep;
            PG8_LDB(B0, 0, 0); PG8_LDB(B1, 0, 1); PG8_SCHED; PG8_LDA(At, 0, 0); PG8_STAGE(PG8_SA(1, 1), a1 + hsA, voffA);
            PG8_WAIT_V(8); PG8_WAIT_L(0); PG8_BAR; PG8_MMA(0, 0, At, B0); PG8_MMA(0, 1, At, B1); PG8_BAR; PG8_SCHED;
            PG8_LDA(At, 0, 1); PG8_STAGE(PG8_SB(0, 0), b2, voffB); PG8_STAGE(PG8_SB(0, 1), b2 + hsB, voffB); PG8_STAGE(PG8_SA(0, 0), a2, voffA);
            PG8_WAIT_V(8); PG8_WAIT_L(0); PG8_BAR; PG8_MMA(1, 0, At, B0); PG8_MMA(1, 1, At, B1); PG8_BAR; PG8_SCHED;
            PG8_LDB(B0, 1, 0); PG8_LDB(B1, 1, 1); PG8_SCHED; PG8_LDA(At, 1, 0); PG8_STAGE(PG8_SA(0, 1), a2 + hsA, voffA);
            PG8_WAIT_V(8); PG8_WAIT_L(0); PG8_BAR; PG8_MMA(0, 0, At, B0); PG8_MMA(0, 1, At, B1); PG8_BAR; PG8_SCHED;
            PG8_LDA(At, 1, 1); PG8_STAGE(PG8_SB(1, 0), b3, voffB); PG8_STAGE(PG8_SB(1, 1), b3 + hsB, voffB); PG8_STAGE(PG8_SA(1, 0), a3, voffA);
            PG8_WAIT_V(8); PG8_WAIT_L(0); PG8_BAR; PG8_MMA(1, 0, At, B0); PG8_MMA(1, 1, At, B1); PG8_BAR; PG8_SCHED;
        }
        if (wr == 0) PG8_BAR;
        E(acc, cur, wr, wc, fr, fq);
        if (!has_next) break;
#pragma unroll
        for (int a = 0; a < 2; ++a)
#pragma unroll
            for (int b = 0; b < 2; ++b)
#pragma unroll
                for (int m = 0; m < 4; ++m)
#pragma unroll
                    for (int n = 0; n < 2; ++n) acc[a][b][m][n] = (f32x4){0.f, 0.f, 0.f, 0.f};
        cur = nxt; cA = nA; cB = nB; ++ui;
        if (wr == 1) PG8_BAR;
    }
    PG8_WAIT_V(0);
    PG8_BAR;
#undef PG8_SA
#undef PG8_SB
#undef PG8_STAGE
#undef PG8_LDA
#undef PG8_LDB
#undef PG8_MMA
#undef PG8_WAIT_V
#undef PG8_WAIT_L
#undef PG8_BAR
#undef PG8_SCHED
}

struct EpiGLU {
    bf16_t* O; int ldc; int coff; const float* rowsq; int mode;
    __device__ __forceinline__ void operator()(const f32x4 (&acc)[2][2][4][2], const Unit& u, int wr, int wc, int fr, int fq) const {
        const int row0 = u.pm * BM + wr * 64 + fr, col0 = coff + u.pn * 128 + wc * 32 + 8 * fq;
#pragma unroll
        for (int ai = 0; ai < 2; ++ai)
#pragma unroll
            for (int m = 0; m < 4; ++m) {
                const int r = row0 + ai * HALF + m * 16;
                float rs = 1.f; if (mode == 0) rs = rsqrtf(rowsq[r] * (1.f / 1024.f) + EPS);
                f32x4 o[2];
#pragma unroll
                for (int n = 0; n < 2; ++n)
#pragma unroll
                    for (int j = 0; j < 4; ++j) { const float a = acc[ai][0][m][n][j] * rs, b = acc[ai][1][m][n][j] * rs;
                        o[n][j] = (mode == 0) ? a * b * sigmoidf_(a) : a * sigmoidf_(b); }
                *(u32x4*)(O + (size_t)r * ldc + col0) = pack8(o[0], o[1]);
            }
    }
};
struct EpiResid {
    const float* Hin; float* Hout; bf16_t* HBo; float* rsn; float scale;
    __device__ __forceinline__ void operator()(const f32x4 (&acc)[2][2][4][2], const Unit& u, int wr, int wc, int fr, int fq) const {
        const int row0 = u.pm * BM + wr * 64 + fr, col0 = u.pn * BM + wc * 32 + 8 * fq;
#pragma unroll
        for (int ai = 0; ai < 2; ++ai)
#pragma unroll
            for (int m = 0; m < 4; ++m) {
                const int r = row0 + ai * HALF + m * 16; float ss = 0.f;
#pragma unroll
                for (int bj = 0; bj < 2; ++bj) { const size_t off = (size_t)r * DM + col0 + bj * HALF;
                    f32x4 h0 = *(const f32x4*)(Hin + off), h1 = *(const f32x4*)(Hin + off + 4);
                    h0 = h0 + acc[ai][bj][m][0] * scale; h1 = h1 + acc[ai][bj][m][1] * scale;
                    *(f32x4*)(Hout + off) = h0; *(f32x4*)(Hout + off + 4) = h1;
                    if (HBo) *(u32x4*)(HBo + off) = pack8(h0, h1);
                    ss += h0[0] * h0[0] + h0[1] * h0[1] + h0[2] * h0[2] + h0[3] * h0[3] + h1[0] * h1[0] + h1[1] * h1[1] + h1[2] * h1[2] + h1[3] * h1[3]; }
                if (rsn) { ss += __shfl_xor(ss, 16); ss += __shfl_xor(ss, 32); if (fq == 0) atomicAdd(rsn + r, ss); }
                __builtin_amdgcn_sched_barrier(0);
            }
    }
};
struct EpiProj {
    bf16_t* O; int ldc; int ncols; const float* rowsq; int act;
    __device__ __forceinline__ void operator()(const f32x4 (&acc)[2][2][4][2], const Unit& u, int wr, int wc, int fr, int fq) const {
        const int row0 = u.pm * BM + wr * 64 + fr, col0 = u.pn * BM + wc * 32 + 8 * fq;
#pragma unroll
        for (int ai = 0; ai < 2; ++ai)
#pragma unroll
            for (int m = 0; m < 4; ++m) {
                const int r = row0 + ai * HALF + m * 16; const float rs = rsqrtf(rowsq[r] * (1.f / 1024.f) + EPS);
#pragma unroll
                for (int bj = 0; bj < 2; ++bj) { const int c = col0 + bj * HALF;
                    if (c < ncols) { f32x4 v0 = acc[ai][bj][m][0] * rs, v1 = acc[ai][bj][m][1] * rs;
                        if (act == 2) {
#pragma unroll
                            for (int j = 0; j < 4; ++j) { v0[j] = sigmoidf_(v0[j]); v1[j] = sigmoidf_(v1[j]); }
                            *((u32x4*)O + ((size_t)((u.pm * 16 + u.pn) * 16 + (ai * 4 + m) * 2 + bj)) * NTHR + threadIdx.x) = pack8(v0, v1); continue; }
                        if (act) {
#pragma unroll
                            for (int j = 0; j < 4; ++j) { v0[j] = sigmoidf_(v0[j]); v1[j] = sigmoidf_(v1[j]); } }
                        *(u32x4*)(O + (size_t)r * ldc + c) = pack8(v0, v1); } }
            }
    }
};
struct EpiPb {
    bf16_t* MX; bf16_t* Gt; int n_;
    __device__ __forceinline__ void operator()(const f32x4 (&acc)[2][2][4][2], const Unit& u, int wr, int wc, int fr, int fq) const {
        int row0 = u.pm * BM + wr * 64 + fr, col0 = u.pn * BM + wc * 32 + 8 * fq; const int n = (n_ < 0) ? u.kind : n_;
        int tl = threadIdx.x; asm volatile("" : "+v"(tl), "+v"(row0));
#pragma unroll
        for (int ai = 0; ai < 2; ++ai)
#pragma unroll
            for (int m = 0; m < 4; ++m) {
                const int r = row0 + ai * HALF + m * 16;
#pragma unroll
                for (int bj = 0; bj < 2; ++bj) { const int c = col0 + bj * HALF;
                    u32x4* gs = (u32x4*)Gt + ((size_t)((u.pm * 16 + n * 4 + u.pn) * 16 + (ai * 4 + m) * 2 + bj)) * NTHR + tl;
                    float g[8]; unpack8(*gs, g); f32x4 p0, p1;
#pragma unroll
                    for (int j = 0; j < 4; ++j) { p0[j] = g[j] * acc[ai][bj][m][0][j]; p1[j] = g[4 + j] * acc[ai][bj][m][1][j]; }
                    if (n > 0) { float o[8]; unpack8(*(gs - (size_t)4 * 16 * NTHR), o);
#pragma unroll
                        for (int j = 0; j < 4; ++j) { p0[j] += o[j]; p1[j] += o[4 + j]; } }
                    if (n < 3) *gs = pack8(p0, p1); else *(u32x4*)(MX + (size_t)r * DM + c) = pack8(p0, p1); }
                __builtin_amdgcn_sched_barrier(0);
            }
    }
};
}

struct Args { const float* in[25]; float* out; unsigned char* ws; int ph_lo, ph_hi; };

__device__ __forceinline__ void tr_item(const float* W, int ldn, int col0, const float* gain, bf16_t* WT, int ldk, int koff, int halfn, int nblk, float* scr, int item, int lane) {
    const int kb = item / nblk, nb = item % nblk, k0 = 64 * kb, n0 = 64 * nb;
    const int n4 = (lane & 15) * 4, kq = lane >> 4;
    f32x4 v[16];
#pragma unroll
    for (int i = 0; i < 16; ++i) v[i] = *(const f32x4*)(W + (size_t)(k0 + 4 * i + kq) * ldn + col0 + n0 + n4);
#pragma unroll
    for (int i = 0; i < 16; ++i) { const int kk = 4 * i + kq; const float gv = gain ? gain[k0 + kk] : 1.f; float* d = scr + kk * 65 + n4;
        d[0] = v[i][0] * gv; d[1] = v[i][1] * gv; d[2] = v[i][2] * gv; d[3] = v[i][3] * gv; }
    LDS_WAIT();
    int rbase = n0;
    if (halfn) { const int half = n0 / halfn, ff = n0 % halfn; rbase = (ff / 128) * 256 + half * 128 + (ff % 128); }
    const int c = lane & 7;
#pragma unroll
    for (int j = 0; j < 8; ++j) { const int n = (lane >> 3) + 8 * j; const float* s = scr + (8 * c) * 65 + n;
        u32x4 o; o.x = cvt_pk_bf16(s[0 * 65], s[1 * 65]); o.y = cvt_pk_bf16(s[2 * 65], s[3 * 65]); o.z = cvt_pk_bf16(s[4 * 65], s[5 * 65]); o.w = cvt_pk_bf16(s[6 * 65], s[7 * 65]);
        *(u32x4*)(WT + (size_t)(rbase + n) * ldk + koff + k0 + 8 * c) = o; }
    LDS_WAIT();
}

__device__ __forceinline__ float wave_sum(float v) {
#pragma unroll
    for (int o = 1; o < 64; o <<= 1) v += __shfl_xor(v, o);
    return v;
}

__device__ __forceinline__ void phase_convert(const Args& a, int l, char* lds, int gw, int NGW, int lane, int wave) {
    unsigned char* ws = a.ws;
    float* scr = (float*)(lds + wave * 16640);
    const float* W1 = a.in[2] + (size_t)l * DM * 2 * FF; const float* W2 = a.in[3] + (size_t)l * FF * DM;
    const float* WIN = a.in[5] + (size_t)l * DM * IN_W;
    const float* WBR = a.in[20] + (size_t)l * 4 * 256 * DM; const float* WO = a.in[21] + (size_t)l * DM * DM;
    const float* W3 = a.in[23] + (size_t)l * DM * 2 * FF; const float* W4 = a.in[24] + (size_t)l * FF * DM;
    const float* WGLU = a.in[14] + (size_t)l * 256 * 512;
    const float* g1 = a.in[1] + l * DM; const float* gm = a.in[4] + l * DM; const float* g2 = a.in[22] + l * DM;
    constexpr int I1 = 16 * 88, I2 = 44 * 16, IP = 16 * 41, IG = 16 * 64, IB = 4 * 4 * 16, IO = 16 * 16, IGL = 4 * 8;
    int off = 0;
#define CONV_LOOP(I, CALL) { int g0 = gw - off; if (g0 < 0) g0 += NGW; for (int r = g0; r < (I); r += NGW) { CALL; } off = (off + (I)) % NGW; }
    CONV_LOOP(I1, tr_item(W1, 2 * FF, 0, g1, (bf16_t*)(ws + WS_W1T), DM, 0, FF, 88, scr, r, lane))
    CONV_LOOP(I2, tr_item(W2, DM, 0, nullptr, (bf16_t*)(ws + WS_W2T), FF, 0, 0, 16, scr, r, lane))
    CONV_LOOP(IP, tr_item(WIN, IN_W, 0, gm, (bf16_t*)(ws + WS_WPT), DM, 0, 0, 41, scr, r, lane))
    CONV_LOOP(IG, tr_item(WIN, IN_W, C_GATE, gm, (bf16_t*)(ws + WS_WGT), DM, 0, 0, 64, scr, r, lane))
    CONV_LOOP(IB, tr_item(WBR + (size_t)(r / 64) * 256 * DM, DM, 0, nullptr, (bf16_t*)(ws + WS_WBT), DM, (r / 64) * 256, 0, 16, scr, r % 64, lane))
    CONV_LOOP(IO, tr_item(WO, DM, 0, nullptr, (bf16_t*)(ws + WS_WOT), DM, 0, 0, 16, scr, r, lane))
    CONV_LOOP(I1, tr_item(W3, 2 * FF, 0, g2, (bf16_t*)(ws + WS_W3T), DM, 0, FF, 88, scr, r, lane))
    CONV_LOOP(I2, tr_item(W4, DM, 0, nullptr, (bf16_t*)(ws + WS_W4T), FF, 0, 0, 16, scr, r, lane))
    CONV_LOOP(IGL, tr_item(WGLU, 512, 0, nullptr, (bf16_t*)(ws + WS_WGLUT), 256, 0, 256, 8, scr, r, lane))
    { u32x4* z = (u32x4*)(ws + WS_WPT + (size_t)2624 * DM * 2); const int nz = 192 * DM * 2 / 16;
      for (int i = gw * 64 + lane; i < nz; i += NGW * 64) z[i] = (u32x4){0u, 0u, 0u, 0u}; }
    { const int gi = gw * 64 + lane;
      if (gi < 1024) { const int g = gi >> 6;
          const float lr = a.in[6][l * 1024 + gi], li = a.in[7][l * 1024 + gi]; const float dt = expf(a.in[8][l * 16 + g]);
          const float er = expf(lr * dt); float sn, cs; sincosf(li * dt, &sn, &cs);
          const float br = er * cs, bi = er * sn;
          const float nr = br - 1.f, ni = bi, den = lr * lr + li * li;
          const float fr = (nr * lr + ni * li) / den, fi = (ni * lr - nr * li) / den;
          f32x2* lamb = (f32x2*)(ws + WS_S5P); f32x2* lam64 = (f32x2*)(ws + WS_S5P + 8192);
          f32x2* bbar = (f32x2*)(ws + WS_S5P + 16384); float* ct = (float*)(ws + WS_S5P + 16384 + 131072);
          lamb[gi] = (f32x2){br, bi};
          float pr = br, pi = bi;
#pragma unroll
          for (int s = 0; s < 6; ++s) { const float tr = pr * pr - pi * pi, ti = 2.f * pr * pi; pr = tr; pi = ti; }
          lam64[gi] = (f32x2){pr, pi};
          const float* bre = a.in[9] + (size_t)l * 16384 + (size_t)gi * 16; const float* bim = a.in[10] + (size_t)l * 16384 + (size_t)gi * 16;
          for (int h = 0; h < 16; ++h) { const float xr = bre[h], xi = bim[h]; bbar[((gi >> 6) * 16 + h) * 64 + (gi & 63)] = (f32x2){fr * xr - fi * xi, fr * xi + fi * xr}; }
          const int p = gi & 63;
          const float* cre = a.in[11] + (size_t)l * 16384 + (size_t)g * 1024; const float* cim = a.in[12] + (size_t)l * 16384 + (size_t)g * 1024;
          for (int h = 0; h < 16; ++h) { ct[gi * 32 + h] = cre[h * 64 + p]; ct[gi * 32 + 16 + h] = cim[h * 64 + p]; }
      } }
    if (l == 0) {
        { float* rq = (float*)(ws + WS_ROWSQ); for (int i = gw * 64 + lane; i < 5 * T; i += NGW * 64) rq[T + i] = 0.f; }
        { float* cs = (float*)(ws + WS_ROPE); float* sn = cs + SEQ * 32;
          for (int i = gw * 64 + lane; i < SEQ * 32; i += NGW * 64) { const int pos = i >> 5, j = i & 31;
              const float inv = powf(10000.f, -(float)(2 * j) / 64.f); const float ang = (float)pos * inv; float s, c; sincosf(ang, &s, &c); cs[i] = c; sn[i] = s; } }
        { const float* x = a.in[0]; bf16_t* hb = (bf16_t*)(ws + WS_HB); float* rq = (float*)(ws + WS_ROWSQ);
          for (int m = gw; m < T; m += NGW) { const f32x4* xr = (const f32x4*)(x + (size_t)m * DM) + lane; float s = 0.f; f32x4 v[4];
#pragma unroll
              for (int j = 0; j < 4; ++j) { v[j] = xr[64 * j]; s += v[j][0] * v[j][0] + v[j][1] * v[j][1] + v[j][2] * v[j][2] + v[j][3] * v[j][3]; }
              s = wave_sum(s); if (lane == 0) rq[m] = s;
              u32x2* o = (u32x2*)(hb + (size_t)m * DM) + lane;
#pragma unroll
              for (int j = 0; j < 4; ++j) o[64 * j] = (u32x2){cvt_pk_bf16(v[j][0], v[j][1]), cvt_pk_bf16(v[j][2], v[j][3])}; } }
    }
}

__device__ __forceinline__ bf16x8 ldfrag(const char* base, int row, int pitch, int k0, int lane) {
    return *(const bf16x8*)(base + ((size_t)(row + (lane & 15)) * pitch + k0 + (lane >> 4) * 8) * 2);
}
#define MFMA16(a, b, c) __builtin_amdgcn_mfma_f32_16x16x32_bf16((a), (b), (c), 0, 0, 0)

__device__ __forceinline__ void dsa_rope_phase(const Args& a, int l, int gw, int NGW, int lane) {
    bf16_t* proj = (bf16_t*)(a.ws + WS_ACT); const float* cs = (const float*)(a.ws + WS_ROPE); const float* sn = cs + SEQ * 32;
    const float* qn = a.in[18] + l * 64; const float* kn = a.in[19] + l * 64;
    const int l32 = lane & 31, vec = l32 >> 2, j = l32 & 3;
    const float* gsrc = (vec < 4) ? qn : kn;
    float ga[8], gb[8];
#pragma unroll
    for (int e = 0; e < 8; ++e) { ga[e] = gsrc[8 * j + e]; gb[e] = gsrc[32 + 8 * j + e]; }
    const float osc = (vec < 4) ? 0.125f : 1.f;
    const int col = (vec < 4) ? (C_DQ + vec * 64) : (C_DK + (vec - 4) * 64);
    for (int pair = gw; pair < T / 2; pair += NGW) {
        const int tok = 2 * pair + (lane >> 5); const int pos = tok & (SEQ - 1);
        bf16_t* p = proj + (size_t)tok * PP + col + 8 * j;
        float x1[8], x2[8]; unpack8(*(const u32x4*)p, x1); unpack8(*(const u32x4*)(p + 32), x2);
        float ss = 0.f;
#pragma unroll
        for (int e = 0; e < 8; ++e) ss += x1[e] * x1[e] + x2[e] * x2[e];
        ss += __shfl_xor(ss, 1); ss += __shfl_xor(ss, 2);
        const float ri = rsqrtf(ss * (1.f / 64.f) + EPS);
        const f32x4* cp = (const f32x4*)(cs + pos * 32 + 8 * j); const f32x4* sp = (const f32x4*)(sn + pos * 32 + 8 * j);
        const f32x4 c0 = cp[0], c1 = cp[1], s0 = sp[0], s1 = sp[1];
        f32x4 o1[2], o2[2];
#pragma unroll
        for (int e = 0; e < 8; ++e) { const float c = (e < 4) ? c0[e & 3] : c1[e & 3], s = (e < 4) ? s0[e & 3] : s1[e & 3];
            const float y1 = x1[e] * ri * ga[e], y2 = x2[e] * ri * gb[e];
            o1[e >> 2][e & 3] = (y1 * c - y2 * s) * osc; o2[e >> 2][e & 3] = (y2 * c + y1 * s) * osc; }
        *(u32x4*)p = pack8(o1[0], o1[1]); *(u32x4*)(p + 32) = pack8(o2[0], o2[1]);
    }
}

__device__ __forceinline__ void s5_load_u(const bf16_t* proj, int b, int c, int g, float* U, int lane) {
    const bf16_t* p = proj + (size_t)(b * SEQ + c * 64 + lane) * PP + C_S5U + g * 16;
    float f[16]; unpack8(*(const u32x4*)p, f); unpack8(*(const u32x4*)(p + 8), f + 8);
    f32x4* d = (f32x4*)(U + lane * 16);
#pragma unroll
    for (int i = 0; i < 4; ++i) d[i] = (f32x4){f[4 * i], f[4 * i + 1], f[4 * i + 2], f[4 * i + 3]};
    LDS_WAIT();
}

__device__ __forceinline__ void s5_pre_phase(const Args& a, char* lds, int gw, int NGW, int lane, int wave) {
    const bf16_t* proj = (const bf16_t*)(a.ws + WS_ACT);
    const f32x2* lamb = (const f32x2*)(a.ws + WS_S5P); const f32x2* bbar = (const f32x2*)(a.ws + WS_S5P + 16384);
    f32x2* E = (f32x2*)(a.ws + WS_S5E);
    float* U = (float*)(lds + wave * 12544); f32x2* BU = (f32x2*)(lds + wave * 12544 + 4096);
    const int i16 = lane & 15, kq = lane >> 4;
    for (int item = gw; item < 4096; item += NGW) {
        const int g = item & 15, c = (item >> 4) & 127, b = item >> 11;
        s5_load_u(proj, b, c, g, U, lane);
        const f32x2 lam = lamb[g * 64 + lane];
        f32x2 ab[4][4];
#pragma unroll
        for (int pt = 0; pt < 4; ++pt)
#pragma unroll
            for (int s2 = 0; s2 < 4; ++s2) ab[pt][s2] = bbar[(g * 16 + 4 * kq + s2) * 64 + pt * 16 + i16];
        float sr = 0.f, si = 0.f;
        for (int tb = 0; tb < 4; ++tb) {
            const f32x4 uv = *(const f32x4*)(U + (tb * 16 + i16) * 16 + 4 * kq);
#pragma unroll
            for (int pt = 0; pt < 4; ++pt) { f32x4 dr = {0.f, 0.f, 0.f, 0.f}, di = {0.f, 0.f, 0.f, 0.f};
#pragma unroll
                for (int s2 = 0; s2 < 4; ++s2) { dr = __builtin_amdgcn_mfma_f32_16x16x4f32(ab[pt][s2][0], uv[s2], dr, 0, 0, 0); di = __builtin_amdgcn_mfma_f32_16x16x4f32(ab[pt][s2][1], uv[s2], di, 0, 0, 0); }
#pragma unroll
                for (int j = 0; j < 4; ++j) BU[i16 * 66 + pt * 16 + kq * 4 + j] = (f32x2){dr[j], di[j]}; }
            LDS_WAIT();
#pragma unroll 4
            for (int tt = 0; tt < 16; ++tt) { const f32x2 v = BU[tt * 66 + lane];
                const float nr = lam[0] * sr - lam[1] * si + v[0], ni = lam[0] * si + lam[1] * sr + v[1]; sr = nr; si = ni; }
            LDS_WAIT();
        }
        E[(size_t)((b * 128 + c) * 16 + g) * 64 + lane] = (f32x2){sr, si};
        LDS_WAIT();
    }
}

constexpr int GL_LA = 0, GL_QE = 8448, GL_KE = GL_QE + 5120, GL_KDT = GL_KE + 5120, GL_VT = GL_KDT + 4608, GL_ATT = GL_VT + 9216, GL_SINT = GL_ATT + 9216, GL_OF = GL_SINT + 5120, GL_END = GL_OF + 16640;
template <bool MAIN>
__device__ __forceinline__ void gla_item(const Args& a, int l, char* lds, int item, int tid, int lane, int wave) {
    const int c = item & 127, h = (item >> 7) & 3, b = item >> 9;
    const bf16_t* proj = (const bf16_t*)(a.ws + WS_ACT);
    float* LA = (float*)(lds + GL_LA); bf16_t* QE = (bf16_t*)(lds + GL_QE); bf16_t* KE = (bf16_t*)(lds + GL_KE); bf16_t* KDT = (bf16_t*)(lds + GL_KDT);
    bf16_t* VT = (bf16_t*)(lds + GL_VT); bf16_t* ATT = (bf16_t*)(lds + GL_ATT); bf16_t* SINT = (bf16_t*)(lds + GL_SINT); float* OF = (float*)(lds + GL_OF);
    const int t = tid >> 3, dg = tid & 7; const size_t tok = (size_t)b * SEQ + c * 64 + t;
    const bf16_t* prow = proj + tok * PP;
    const u32x4 ld_g0 = *(const u32x4*)(prow + C_GG), ld_g1 = *(const u32x4*)(prow + C_GG + 8);
    const u32x2 ld_q = *(const u32x2*)(prow + C_GQ + h * 32 + dg * 4), ld_k = *(const u32x2*)(prow + C_GK + h * 32 + dg * 4);
    const u32x4 ld_v = *(const u32x4*)(prow + C_GV + h * 64 + dg * 8);
    u32x4 ld_r = {0u, 0u, 0u, 0u}; f32x4 ld_s = {0.f, 0.f, 0.f, 0.f};
    if (MAIN) { ld_r = *(const u32x4*)(prow + C_GR + h * 64 + dg * 8);
        ld_s = *(const f32x4*)((const float*)(a.ws + WS_GSI) + (size_t)((b * 4 + h) * 128 + c) * 2048 + tid * 4); }
    { float g1[16]; unpack8(ld_g0, g1); unpack8(ld_g1, g1 + 8);
      const float* wg = a.in[15] + (size_t)l * 16 * 128 + h * 32 + dg * 4; const float* bg = a.in[16] + l * 128 + h * 32 + dg * 4;
      f32x4 z4 = *(const f32x4*)bg;
#pragma unroll
      for (int r = 0; r < 16; ++r) z4 = z4 + *(const f32x4*)(wg + r * 128) * g1[r];
#pragma unroll
      for (int dd = 0; dd < 4; ++dd) { const float z = z4[dd];
          const float ls = fminf(z, 0.f) - log1pf(__expf(-fabsf(z)));
          LA[t * 33 + dg * 4 + dd] = ls * (1.f / 16.f); } }
    __syncthreads();
#pragma unroll
    for (int dd = 0; dd < 4; ++dd) { const int d = wave * 4 + dd; float v = LA[lane * 33 + d];
#pragma unroll
        for (int o = 1; o < 64; o <<= 1) { const float y = __shfl_up(v, o); if (lane >= o) v += y; }
        LA[lane * 33 + d] = v; }
    __syncthreads();
    { float q4[4], k4[4];
      { const u32x2 qv = ld_q; const u32x2 kv = ld_k;
        q4[0] = bflo(qv.x); q4[1] = bfhi(qv.x); q4[2] = bflo(qv.y); q4[3] = bfhi(qv.y); k4[0] = bflo(kv.x); k4[1] = bfhi(kv.x); k4[2] = bflo(kv.y); k4[3] = bfhi(kv.y); }
#pragma unroll
      for (int dd = 0; dd < 4; ++dd) { const int d = dg * 4 + dd; const float bc = LA[t * 33 + d], bl = LA[63 * 33 + d];
          if (MAIN) { QE[t * 40 + d] = f2bf(q4[dd] * __expf(bc) * 0.17677669529663687f); KE[t * 40 + d] = f2bf(k4[dd] * __expf(-bc)); }
          else KDT[d * 72 + t] = f2bf(k4[dd] * __expf(bl - bc)); }
      float v8[8]; unpack8(ld_v, v8);
#pragma unroll
      for (int e = 0; e < 8; ++e) VT[(dg * 8 + e) * 72 + t] = f2bf(v8[e]);
      if (MAIN) { const f32x4 sv = ld_s; const int d = (tid * 4) >> 6, e0 = (tid * 4) & 63;
#pragma unroll
          for (int i = 0; i < 4; ++i) SINT[(e0 + i) * 40 + d] = f2bf(sv[i]); } }
    __syncthreads();
    if (!MAIN) {
        const int dt = wave >> 2, et = wave & 3; f32x4 acc = {0.f, 0.f, 0.f, 0.f};
#pragma unroll
        for (int ks = 0; ks < 2; ++ks) acc = MFMA16(ldfrag((const char*)KDT, dt * 16, 72, ks * 32, lane), ldfrag((const char*)VT, et * 16, 72, ks * 32, lane), acc);
        float* Sl = (float*)(a.ws + WS_GSL) + (size_t)((b * 4 + h) * 128 + c) * 2048;
#pragma unroll
        for (int j = 0; j < 4; ++j) Sl[(dt * 16 + (lane >> 4) * 4 + j) * 64 + et * 16 + (lane & 15)] = acc[j];
        if (tid < 32) ((float*)(a.ws + WS_GBL))[(size_t)((b * 4 + h) * 128 + c) * 32 + tid] = LA[63 * 33 + tid];
        __syncthreads();
        return;
    } else {
#pragma unroll
        for (int x = 0; x < 2; ++x) { const int id = wave * 2 + x, it = id >> 2, jt = id & 3; f32x4 acc = {0.f, 0.f, 0.f, 0.f};
            if (jt <= it) acc = MFMA16(ldfrag((const char*)QE, it * 16, 40, 0, lane), ldfrag((const char*)KE, jt * 16, 40, 0, lane), acc);
#pragma unroll
            for (int j = 0; j < 4; ++j) { const int i_ = it * 16 + (lane >> 4) * 4 + j, j_ = jt * 16 + (lane & 15); ATT[i_ * 72 + j_] = (j_ <= i_) ? f2bf(acc[j]) : (bf16_t)0; } }
        __syncthreads();
#pragma unroll
        for (int x = 0; x < 2; ++x) { const int id = wave * 2 + x, it = id >> 2, et = id & 3; f32x4 acc = {0.f, 0.f, 0.f, 0.f};
#pragma unroll
            for (int ks = 0; ks < 2; ++ks) acc = MFMA16(ldfrag((const char*)ATT, it * 16, 72, ks * 32, lane), ldfrag((const char*)VT, et * 16, 72, ks * 32, lane), acc);
            acc = MFMA16(ldfrag((const char*)QE, it * 16, 40, 0, lane), ldfrag((const char*)SINT, et * 16, 40, 0, lane), acc);
#pragma unroll
            for (int j = 0; j < 4; ++j) OF[(it * 16 + (lane >> 4) * 4 + j) * 65 + et * 16 + (lane & 15)] = acc[j]; }
        __syncthreads();
        { float o[8]; float ss = 0.f;
#pragma unroll
          for (int e = 0; e < 8; ++e) { o[e] = OF[t * 65 + dg * 8 + e]; ss += o[e] * o[e]; }
          ss += __shfl_xor(ss, 1); ss += __shfl_xor(ss, 2); ss += __shfl_xor(ss, 4);
          const float ri = rsqrtf(ss * (1.f / 64.f) + EPS);
          float r8[8]; unpack8(ld_r, r8);
          const float* gn = a.in[17] + l * 256 + h * 64 + dg * 8; f32x4 w0, w1;
#pragma unroll
          for (int e = 0; e < 8; ++e) { float v = o[e] * ri * gn[e] * (r8[e] * sigmoidf_(r8[e]));

              if (e < 4) w0[e] = v; else w1[e - 4] = v; }
          *(u32x4*)((bf16_t*)(a.ws + WS_BR) + tok * DM + 512 + h * 64 + dg * 8) = pack8(w0, w1); }
        __syncthreads();
    }
}

__device__ __forceinline__ void s5_scan(const Args& a, int ch) {
    const int b = ch >> 10, gp = ch & 1023;
    const f32x2 l64 = ((const f32x2*)(a.ws + WS_S5P + 8192))[gp];
    const f32x2* E = (const f32x2*)(a.ws + WS_S5E) + (size_t)b * 128 * 1024 + gp; f32x2* C = (f32x2*)(a.ws + WS_S5C) + (size_t)b * 128 * 1024 + gp;
    float cr = 0.f, ci = 0.f;
    for (int c0 = 0; c0 < 128; c0 += 16) { f32x2 e[16];
#pragma unroll
        for (int i = 0; i < 16; ++i) e[i] = E[(size_t)(c0 + i) * 1024];
#pragma unroll
        for (int i = 0; i < 16; ++i) { C[(size_t)(c0 + i) * 1024] = (f32x2){cr, ci}; const float nr = l64[0] * cr - l64[1] * ci + e[i][0], ni = l64[0] * ci + l64[1] * cr + e[i][1]; cr = nr; ci = ni; } }
}
__device__ __forceinline__ void gla_scan(const Args& a, int idx) {
    const int bh = idx >> 11, de = idx & 2047, d = de >> 6;
    const float* Sl = (const float*)(a.ws + WS_GSL) + (size_t)bh * 128 * 2048 + de; float* Si = (float*)(a.ws + WS_GSI) + (size_t)bh * 128 * 2048 + de;
    const float* bl = (const float*)(a.ws + WS_GBL) + (size_t)bh * 128 * 32 + d;
    float s = 0.f;
    for (int c0 = 0; c0 < 128; c0 += 16) { float x[16], g[16];
#pragma unroll
        for (int i = 0; i < 16; ++i) { x[i] = Sl[(size_t)(c0 + i) * 2048]; g[i] = bl[(c0 + i) * 32]; }
#pragma unroll
        for (int i = 0; i < 16; ++i) { Si[(size_t)(c0 + i) * 2048] = s; s = __expf(g[i]) * s + x[i]; } }
}

constexpr int AT_KS = 0, AT_VT = 9216, AT_BUF = 18432;
__device__ __forceinline__ void attn_load(const bf16_t* proj, size_t tokbase, int kcol, int vcol, int tid, u32x4& kv, u32x4& vv) {
    const int key = tid & 63, c8 = tid >> 6;
    const bf16_t* p = proj + (tokbase + key) * PP;
    kv = *(const u32x4*)(p + kcol + c8 * 8); vv = *(const u32x4*)(p + vcol + c8 * 8);
}
__device__ __forceinline__ void attn_store(char* lds, int tid, const u32x4& kv, const u32x4& vv) {
    const int key = tid & 63, c8 = tid >> 6;
    const int rho = ((key >> 2) & 3) * 16 + (key >> 4) * 4 + (key & 3);
    *(u32x4*)(lds + AT_KS + (rho * 72 + c8 * 8) * 2) = kv;
    bf16_t* VT = (bf16_t*)(lds + AT_VT);
    const unsigned w[4] = {vv.x, vv.y, vv.z, vv.w};
#pragma unroll
    for (int e = 0; e < 4; ++e) { VT[(c8 * 8 + 2 * e) * 72 + key] = (bf16_t)(w[e] & 0xffffu); VT[(c8 * 8 + 2 * e + 1) * 72 + key] = (bf16_t)(w[e] >> 16); }
}

__device__ __forceinline__ void sb_item(const Args& a, char* lds, int item, int tid, int lane, int wave) {
    const int qb = item & 63, h = (item >> 6) & 3, b = item >> 8; const int q0 = qb * 128;
    const bf16_t* proj = (const bf16_t*)(a.ws + WS_ACT);
    const int fr = lane & 15, fq = lane >> 4; const int qpos = q0 + wave * 16 + fr;
    bf16x8 qf[2];
    { const bf16_t* qp = proj + ((size_t)b * SEQ + qpos) * PP + C_SBQ + h * 64 + fq * 8; qf[0] = *(const bf16x8*)qp; qf[1] = *(const bf16x8*)(qp + 32); }
    f32x4 o[4];
#pragma unroll
    for (int i = 0; i < 4; ++i) o[i] = (f32x4){0.f, 0.f, 0.f, 0.f};
    float R = 1.f;
    u32x4 kvr, vvr; attn_load(proj, (size_t)b * SEQ + ((q0 >> 6) + 1) * 64, C_SBK + h * 64, C_SBV + h * 64, tid, kvr, vvr);
    attn_store(lds, tid, kvr, vvr);
    __syncthreads();
    attn_load(proj, (size_t)b * SEQ + (q0 >> 6) * 64, C_SBK + h * 64, C_SBV + h * 64, tid, kvr, vvr);
    int buf = 0;
    for (int jt = (q0 >> 6) + 1; jt >= 0; --jt) {
        char* L = lds + buf * AT_BUF;
        f32x4 s[4];
#pragma unroll
        for (int i = 0; i < 4; ++i) { s[i] = (f32x4){0.f, 0.f, 0.f, 0.f};
#pragma unroll
            for (int ks = 0; ks < 2; ++ks) s[i] = MFMA16(ldfrag(L + AT_KS, i * 16, 72, ks * 32, lane), qf[ks], s[i]); }
        const int kbase = jt * 64 + fq * 16;
        float w[16]; float suf = 1.f;
#pragma unroll
        for (int kk = 15; kk >= 0; --kk) { const float z = fminf(s[kk >> 2][kk & 3] * 0.125f, 80.f); const float e = __expf(z); float keep = __builtin_amdgcn_rcpf(1.f + e); float beta = e * keep;
            if (kbase + kk >= qpos) { keep = 1.f; beta = 0.f; }
            w[kk] = beta * suf; suf *= keep; }
        const float t1 = __shfl(suf, (lane + 16) & 63), t2 = __shfl(suf, (lane + 32) & 63), t3 = __shfl(suf, (lane + 48) & 63);
        float mult = R; if (fq < 3) mult *= t1; if (fq < 2) mult *= t2; if (fq < 1) mult *= t3;
        float tot = suf * __shfl_xor(suf, 16); tot *= __shfl_xor(tot, 32);
        R *= tot;
        bf16x8 pb[2];
#pragma unroll
        for (int s2 = 0; s2 < 2; ++s2) { u32x4 pk; pk.x = cvt_pk_bf16(w[s2 * 8 + 0] * mult, w[s2 * 8 + 1] * mult); pk.y = cvt_pk_bf16(w[s2 * 8 + 2] * mult, w[s2 * 8 + 3] * mult);
            pk.z = cvt_pk_bf16(w[s2 * 8 + 4] * mult, w[s2 * 8 + 5] * mult); pk.w = cvt_pk_bf16(w[s2 * 8 + 6] * mult, w[s2 * 8 + 7] * mult); pb[s2] = __builtin_bit_cast(bf16x8, pk); }
#pragma unroll
        for (int dt = 0; dt < 4; ++dt)
#pragma unroll
            for (int s2 = 0; s2 < 2; ++s2) { const bf16x8 vf = *(const bf16x8*)(L + AT_VT + ((dt * 16 + fr) * 72 + fq * 16 + s2 * 8) * 2); o[dt] = MFMA16(vf, pb[s2], o[dt]); }
        const int alive = !(R < 1e-35f);
        if (jt > 0) attn_store(lds + (buf ^ 1) * AT_BUF, tid, kvr, vvr);
        if (!__syncthreads_or(alive)) break;
        if (jt > 1) attn_load(proj, (size_t)b * SEQ + (jt - 2) * 64, C_SBK + h * 64, C_SBV + h * 64, tid, kvr, vvr);
        buf ^= 1;
    }
    bf16_t* op = (bf16_t*)(a.ws + WS_BR) + ((size_t)b * SEQ + qpos) * DM + 0 + h * 64 + fq * 4;
#pragma unroll
    for (int dt = 0; dt < 4; ++dt) *(u32x2*)(op + dt * 16) = (u32x2){cvt_pk_bf16(o[dt][0], o[dt][1]), cvt_pk_bf16(o[dt][2], o[dt][3])};
    __syncthreads();
}

__device__ __forceinline__ void dsa_item(const Args& a, int l, char* lds, int item, int tid, int lane, int wave) {
    const int qb = item & 63, h = (item >> 6) & 3, b = item >> 8; const int q0 = qb * 128;
    const bf16_t* proj = (const bf16_t*)(a.ws + WS_ACT);
    const int fr = lane & 15, fq = lane >> 4; const int qpos = q0 + wave * 16 + fr;
    float bound;
    { float gq = fabsf(a.in[18][l * 64 + lane]), gk = fabsf(a.in[19][l * 64 + lane]);
#pragma unroll
      for (int o = 1; o < 64; o <<= 1) { gq = fmaxf(gq, __shfl_xor(gq, o)); gk = fmaxf(gk, __shfl_xor(gk, o)); }
      bound = 8.f * gq * gk * 1.02f; }
    bf16x8 qf[2];
    { const bf16_t* qp = proj + ((size_t)b * SEQ + qpos) * PP + C_DQ + h * 64 + fq * 8; qf[0] = *(const bf16x8*)qp; qf[1] = *(const bf16x8*)(qp + 32); }
    f32x4 o[4];
#pragma unroll
    for (int i = 0; i < 4; ++i) o[i] = (f32x4){0.f, 0.f, 0.f, 0.f};
    float lsum = 0.f;
    int jlo = (q0 - 2048) >> 6; if (jlo < 0) jlo = 0;
    u32x4 kvr, vvr; attn_load(proj, (size_t)b * SEQ + ((q0 >> 6) + 1) * 64, C_DK + h * 64, C_DV + h * 64, tid, kvr, vvr);
    attn_store(lds, tid, kvr, vvr);
    __syncthreads();
    attn_load(proj, (size_t)b * SEQ + (q0 >> 6) * 64, C_DK + h * 64, C_DV + h * 64, tid, kvr, vvr);
    int buf = 0;
    for (int jt = (q0 >> 6) + 1; jt >= jlo; --jt) {
        char* L = lds + buf * AT_BUF;
        f32x4 s[4];
#pragma unroll
        for (int i = 0; i < 4; ++i) { s[i] = (f32x4){0.f, 0.f, 0.f, 0.f};
#pragma unroll
            for (int ks = 0; ks < 2; ++ks) s[i] = MFMA16(ldfrag(L + AT_KS, i * 16, 72, ks * 32, lane), qf[ks], s[i]); }
        const int d0 = qpos - (jt * 64 + fq * 16);
        const int dmin = (q0 + wave * 16) - (jt * 64 + 63);
        float w[16];
        if (dmin > 512) {
            const int ks_ = d0 & 15, ci = ks_ & 3, ii = ks_ >> 2; const int d = d0 - ks_;
            const f32x4 sv = (ii == 0) ? s[0] : (ii == 1) ? s[1] : (ii == 2) ? s[2] : s[3];
            const float val = (ci == 0) ? sv[0] : (ci == 1) ? sv[1] : (ci == 2) ? sv[2] : sv[3];
            const float p = (d >= 0 && d <= 2048) ? __expf(val - bound) : 0.f;
            lsum += p;
#pragma unroll
            for (int kk = 0; kk < 16; ++kk) w[kk] = (kk == ks_) ? p : 0.f;
        } else if (dmin > 128) {
            const int ci = d0 & 3;
#pragma unroll
            for (int i = 0; i < 4; ++i) { const float val = (ci == 0) ? s[i][0] : (ci == 1) ? s[i][1] : (ci == 2) ? s[i][2] : s[i][3];
                const int d = d0 - (4 * i + ci);
                const int m = ((d <= 512) ? 1 : 0) + ((d <= 2048 && (d & 15) == 0) ? 1 : 0) + ((d <= 128) ? 1 : 0);
                const float p = (d >= 0 && m > 0) ? (float)m * __expf(val - bound) : 0.f;
                lsum += p;
#pragma unroll
                for (int c = 0; c < 4; ++c) w[4 * i + c] = (c == ci) ? p : 0.f; }
        } else {
#pragma unroll
            for (int kk = 0; kk < 16; ++kk) { const int d = d0 - kk;
                const int m = (d <= 128 ? 1 : 0) + ((d <= 512 && (d & 3) == 0) ? 1 : 0) + ((d <= 2048 && (d & 15) == 0) ? 1 : 0);
                const float p = (d >= 0 && m > 0) ? (float)m * __expf(s[kk >> 2][kk & 3] - bound) : 0.f;
                w[kk] = p; lsum += p; }
        }
        bf16x8 pb[2];
#pragma unroll
        for (int s2 = 0; s2 < 2; ++s2) { u32x4 pk; pk.x = cvt_pk_bf16(w[s2 * 8 + 0], w[s2 * 8 + 1]); pk.y = cvt_pk_bf16(w[s2 * 8 + 2], w[s2 * 8 + 3]);
            pk.z = cvt_pk_bf16(w[s2 * 8 + 4], w[s2 * 8 + 5]); pk.w = cvt_pk_bf16(w[s2 * 8 + 6], w[s2 * 8 + 7]); pb[s2] = __builtin_bit_cast(bf16x8, pk); }
#pragma unroll
        for (int dt = 0; dt < 4; ++dt)
#pragma unroll
            for (int s2 = 0; s2 < 2; ++s2) { const bf16x8 vf = *(const bf16x8*)(L + AT_VT + ((dt * 16 + fr) * 72 + fq * 16 + s2 * 8) * 2); o[dt] = MFMA16(vf, pb[s2], o[dt]); }
        if (jt > jlo) attn_store(lds + (buf ^ 1) * AT_BUF, tid, kvr, vvr);
        __syncthreads();
        if (jt > jlo + 1) attn_load(proj, (size_t)b * SEQ + (jt - 2) * 64, C_DK + h * 64, C_DV + h * 64, tid, kvr, vvr);
        buf ^= 1;
    }
    lsum += __shfl_xor(lsum, 16); lsum += __shfl_xor(lsum, 32);
    const float inv = 1.f / lsum;
    bf16_t* op = (bf16_t*)(a.ws + WS_BR) + ((size_t)b * SEQ + qpos) * DM + 768 + h * 64 + fq * 4;
#pragma unroll
    for (int dt = 0; dt < 4; ++dt) *(u32x2*)(op + dt * 16) = (u32x2){cvt_pk_bf16(o[dt][0] * inv, o[dt][1] * inv), cvt_pk_bf16(o[dt][2] * inv, o[dt][3] * inv)};
}

__device__ __forceinline__ float gelu_tanh(float x) { const float u = 0.7978845608028654f * (x + 0.044715f * x * x * x); const float e = __expf(2.f * u); const float th = 1.f - 2.f * __builtin_amdgcn_rcpf(e + 1.f); return 0.5f * x * (1.f + th); }
__device__ __forceinline__ void s5_main_item(const Args& a, int l, char* lds, int item, int lane, int wave) {
    const int c = item & 127, b = item >> 7;
    const bf16_t* proj = (const bf16_t*)(a.ws + WS_ACT);
    const f32x2* lamb = (const f32x2*)(a.ws + WS_S5P); const f32x2* bbar = (const f32x2*)(a.ws + WS_S5P + 16384); const float* ct = (const float*)(a.ws + WS_S5P + 16384 + 131072);
    const f32x2* C = (const f32x2*)(a.ws + WS_S5C); bf16_t* Y = (bf16_t*)(a.ws + WS_YS5);
    float* U = (float*)(lds + wave * 12544); f32x2* ST = (f32x2*)(lds + wave * 12544 + 4096);
    for (int gi = 0; gi < 2; ++gi) { const int g = wave * 2 + gi;
        s5_load_u(proj, b, c, g, U, lane);
        const f32x2 lam = lamb[g * 64 + lane];
        const f32x2* abp = bbar + (size_t)(g * 16 + 4 * (lane >> 4)) * 64 + (lane & 15);
        const f32x2 c0 = C[(size_t)((b * 128 + c) * 16 + g) * 64 + lane];
        float sr = c0[0], si = c0[1];
        const int tt2 = lane & 15, hq = lane >> 4;
        const f32x4 dsk = *(const f32x4*)(a.in[13] + l * 256 + g * 16 + hq * 4);
        for (int tb = 0; tb < 4; ++tb) {
            { const f32x4 uvp = *(const f32x4*)(U + (tb * 16 + tt2) * 16 + 4 * hq);
#pragma unroll
              for (int pt = 0; pt < 4; ++pt) { f32x4 dr = {0.f, 0.f, 0.f, 0.f}, di = {0.f, 0.f, 0.f, 0.f};
#pragma unroll
                  for (int s2 = 0; s2 < 4; ++s2) { const f32x2 av = abp[s2 * 64 + pt * 16]; dr = __builtin_amdgcn_mfma_f32_16x16x4f32(av[0], uvp[s2], dr, 0, 0, 0); di = __builtin_amdgcn_mfma_f32_16x16x4f32(av[1], uvp[s2], di, 0, 0, 0); }
#pragma unroll
                  for (int j = 0; j < 4; ++j) ST[tt2 * 66 + pt * 16 + hq * 4 + j] = (f32x2){dr[j], di[j]}; } }
            LDS_WAIT();
#pragma unroll 4
            for (int tt = 0; tt < 16; ++tt) { const f32x2 v = ST[tt * 66 + lane];
                const float nr = lam[0] * sr - lam[1] * si + v[0], ni = lam[0] * si + lam[1] * sr + v[1]; sr = nr; si = ni;
                ST[tt * 66 + lane] = (f32x2){sr, si}; }
            LDS_WAIT();
            f32x4 y = {0.f, 0.f, 0.f, 0.f};
            { const f32x4* sp = (const f32x4*)((const float*)ST + tt2 * 132 + hq * 32);
#pragma unroll
              for (int q = 0; q < 8; ++q) { const f32x4 sv = sp[q];
                  const float* cp = ct + (size_t)(g * 64 + hq * 16 + 2 * q) * 32 + tt2;
                  const float c0 = cp[0], c1 = -cp[16], c2 = cp[32], c3 = -cp[48];
                  y = __builtin_amdgcn_mfma_f32_16x16x4f32(c0, sv[0], y, 0, 0, 0); y = __builtin_amdgcn_mfma_f32_16x16x4f32(c1, sv[1], y, 0, 0, 0);
                  y = __builtin_amdgcn_mfma_f32_16x16x4f32(c2, sv[2], y, 0, 0, 0); y = __builtin_amdgcn_mfma_f32_16x16x4f32(c3, sv[3], y, 0, 0, 0); } }
            const int t = tb * 16 + tt2; const f32x4 uv = *(const f32x4*)(U + t * 16 + hq * 4);
            y = y + dsk * uv;
            *(u32x2*)(Y + ((size_t)b * SEQ + c * 64 + t) * 256 + g * 16 + hq * 4) = (u32x2){cvt_pk_bf16(gelu_tanh(y[0]), gelu_tanh(y[1])), cvt_pk_bf16(gelu_tanh(y[2]), gelu_tanh(y[3]))};
            LDS_WAIT();
        }
    }
}

#define XB_TMO      128
#define XB_XCNT(j)  (256  + 64 * (j))
#define XB_XSUB(j)  (1280 + 64 * (j))
#define XB_XGEN(j)  (2304 + 64 * (j))
#define XB_TOP      3328
#define XB_TOPGEN   3392
#define XCD_BAR_WORDS 3456
#define XB_SPIN_CAP (1u << 18)
__device__ __forceinline__ unsigned xb_ld(unsigned* p)              { return __hip_atomic_load(p, __ATOMIC_RELAXED, __HIP_MEMORY_SCOPE_AGENT); }
__device__ __forceinline__ unsigned xb_add(unsigned* p, unsigned v) { return __hip_atomic_fetch_add(p, v, __ATOMIC_RELAXED, __HIP_MEMORY_SCOPE_AGENT); }
__device__ __forceinline__ unsigned xb_xcc_id() { return (unsigned)__builtin_amdgcn_s_getreg((3 << 11) | 20) & 0xFu; }
#define XB_SPIN(cond, bar) do { unsigned _sp = 0; while (cond) { __builtin_amdgcn_s_sleep(1); \
    if ((++_sp & 255u) == 0u) { if (xb_ld(&(bar)[XB_TMO])) break; if (_sp > XB_SPIN_CAP) { atomicAdd(&(bar)[XB_TMO], 1u); break; } } } } while (0)
__device__ __forceinline__ void xcd_barrier_complete(unsigned* bar, unsigned x, unsigned& nloc, unsigned& nx) {
    const unsigned G = gridDim.x * gridDim.y * gridDim.z;
    unsigned sum, cnt, mine, sp = 0u;
    for (;;) {
        sum = 0u; cnt = 0u; mine = 0u;
#pragma unroll
        for (unsigned j = 0; j < 16; ++j) { const unsigned c = xb_ld(&bar[XB_XCNT(j)]); sum += c; cnt += (c > 0u) ? 1u : 0u; mine = (j == x) ? c : mine; }
        if (sum == G) break;
        __builtin_amdgcn_s_sleep(1);
        if ((++sp & 255u) == 0u) { if (xb_ld(&bar[XB_TMO])) break; if (sp > XB_SPIN_CAP) { atomicAdd(&bar[XB_TMO], 1u); break; } }
    }
    nloc = mine > 0u ? mine : 1u; nx = cnt > 0u ? cnt : 1u;
}
__device__ __forceinline__ void xcd_barrier(unsigned* bar, volatile LAS unsigned* st) {
    asm volatile("s_waitcnt vmcnt(0)" ::: "memory");
    __syncthreads();
    if (threadIdx.x == 0) {
        const unsigned x = xb_xcc_id();
        __builtin_amdgcn_s_waitcnt(0);
        unsigned nloc = st[0], nx = st[1];
        if (nloc == 0u) { xcd_barrier_complete(bar, x, nloc, nx); st[0] = nloc; st[1] = nx; }
        const unsigned old = xb_add(&bar[XB_XSUB(x)], 1u);
        const unsigned gen = old / nloc;
        if (old + 1u == (gen + 1u) * nloc) {
            __builtin_amdgcn_fence(__ATOMIC_RELEASE, "agent");
            asm volatile("s_waitcnt vmcnt(0)" ::: "memory");
            const unsigned og = xb_add(&bar[XB_TOP], 1u);
            const unsigned tg = og / nx;
            if (og + 1u == (tg + 1u) * nx) xb_add(&bar[XB_TOPGEN], 1u);
            else XB_SPIN(xb_ld(&bar[XB_TOPGEN]) == tg, bar);
            __builtin_amdgcn_fence(__ATOMIC_ACQUIRE, "agent");
            xb_add(&bar[XB_XGEN(x)], 1u);
            asm volatile("s_waitcnt vmcnt(0)" ::: "memory");
        } else {
            XB_SPIN(xb_ld(&bar[XB_XGEN(x)]) == gen, bar);
            __builtin_amdgcn_fence(__ATOMIC_ACQUIRE, "agent");
            asm volatile("s_waitcnt vmcnt(0)" ::: "memory");
        }
    }
    __syncthreads();
}
constexpr int LDS_BARST = LDS_BYTES - 64;

enum { PH_CONV = 0, PH_FFN1A, PH_FFN1B, PH_PROJ, PH_MIXPRE, PH_MIXA, PH_MIXB, PH_GLU, PH_GATE, PH_PB0, PH_WOUT, PH_FFN2A, PH_FFN2B, PH_PER_LAYER };
constexpr int N_PHASES = 2 * PH_PER_LAYER;

#ifndef ENMASK
#define ENMASK 0xFFFFF
#endif
typedef const __attribute__((address_space(4))) Args* KArgP;
__device__ __forceinline__ Args load_args() {
#if defined(__HIP_DEVICE_COMPILE__)
    KArgP p = (KArgP)__builtin_amdgcn_kernarg_segment_ptr(); asm volatile("" : "+s"(p)); Args r;
#pragma unroll
    for (int i = 0; i < 25; ++i) r.in[i] = p->in[i];
    r.out = p->out; r.ws = p->ws; r.ph_lo = p->ph_lo; r.ph_hi = p->ph_hi; return r;
#else
    return Args{};
#endif
}
#ifndef DUPMASK
#define DUPMASK 0
#endif
#define REP(k) for (int rep_ = 0; rep_ < 1 + ((DUPMASK >> (k)) & 1); ++rep_)
#define RUN(k) (((ENMASK >> (k)) & 1) && lo <= l * PH_PER_LAYER + (k) && l * PH_PER_LAYER + (k) < hi)
#define SEAM(k) do { if (l * PH_PER_LAYER + (k) + 1 < hi) xcd_barrier((unsigned*)(load_args().ws + WS_BARW), (volatile LAS unsigned*)(ldsl + LDS_BARST)); } while (0)
template <int l>
__device__ __forceinline__ void layer_body(int lo, int hi, cg::grid_group& grid, LAS unsigned char* ldsl, char* lds) {
    const int tid = threadIdx.x, lane = tid & 63, wave = __builtin_amdgcn_readfirstlane(tid >> 6);
    const int G = gridDim.x, bx = blockIdx.x; const int gw = bx * NWAVES + wave, NGW = G * NWAVES;
#define PH_LOCALS const Args a = load_args(); unsigned char* ws = a.ws; float* rowsq = (float*)(ws + WS_ROWSQ); \
    bf16_t* HB = (bf16_t*)(ws + WS_HB); bf16_t* ACT = (bf16_t*)(ws + WS_ACT); bf16_t* BR = (bf16_t*)(ws + WS_BR); bf16_t* MX = (bf16_t*)(ws + WS_MIX); \
    (void)rowsq; (void)HB; (void)ACT; (void)BR; (void)MX;
        if (RUN(PH_CONV)) REP(PH_CONV) { PH_LOCALS phase_convert(a, l, lds, gw, NGW, lane, wave); SEAM(PH_CONV); }
        if (RUN(PH_FFN1A)) REP(PH_FFN1A) { PH_LOCALS
            pg8::StdSched S; S.init(HB, ws + WS_W1T, T, 2 * FF, DM, DM, DM, G, bx);
            pg8::EpiGLU E{ACT, FF, 0, rowsq + (size_t)(l * 3 + 0) * T, 0};
            pg8::gemm_phase(ldsl, DM, DM, S, E); SEAM(PH_FFN1A); }
        if (RUN(PH_FFN1B)) REP(PH_FFN1B) { PH_LOCALS
            pg8::StdSched S; S.init(ACT, ws + WS_W2T, T, DM, FF, FF, FF, G, bx);
            pg8::EpiResid E{l == 0 ? a.in[0] : a.out, a.out, HB, rowsq + (size_t)(l * 3 + 1) * T, 0.5f};
            pg8::gemm_phase(ldsl, FF, FF, S, E); SEAM(PH_FFN1B); }
        if (RUN(PH_PROJ)) REP(PH_PROJ) { PH_LOCALS
            pg8::StdSched S; S.init(HB, ws + WS_WPT, T, PP, DM, DM, DM, G, bx);
            pg8::EpiProj E{ACT, PP, C_GATE, rowsq + (size_t)(l * 3 + 1) * T, 0};
            pg8::gemm_phase(ldsl, DM, DM, S, E); SEAM(PH_PROJ); }
        if (RUN(PH_MIXPRE)) REP(PH_MIXPRE) { PH_LOCALS
#ifndef NO_S5
            dsa_rope_phase(a, l, gw, NGW, lane);
            s5_pre_phase(a, lds, gw, NGW, lane, wave);
#endif
            __syncthreads();
            for (int it = bx; it < 1024; it += G) gla_item<false>(a, l, lds, it, tid, lane, wave);
            SEAM(PH_MIXPRE); }
        if (RUN(PH_MIXA)) { PH_LOCALS
            unsigned* qctr = (unsigned*)(ws + WS_BARW) + XCD_BAR_WORDS + l; volatile LAS unsigned* qslot = (volatile LAS unsigned*)(ldsl + LDS_BARST + 16);
            if (bx < 4) s5_scan(a, bx * NTHR + tid);
            else if (bx < 36) gla_scan(a, (bx - 4) * NTHR + tid);
            for (;;) {
                if (tid == 0) *qslot = xb_add(qctr, 1u);
                __syncthreads();
                const int it = __builtin_amdgcn_readfirstlane((int)*qslot);
                __syncthreads();
                if (it >= 1024) break;
                if (it < 512) dsa_item(a, l, lds, it ^ 63, tid, lane, wave);
                else sb_item(a, lds, it - 512, tid, lane, wave);
            }
            SEAM(PH_MIXA); }
        if (RUN(PH_MIXB)) REP(PH_MIXB) { PH_LOCALS
            for (int it = bx; it < 1280; it += G) { if (it < 256) {
#ifndef NO_S5
                s5_main_item(a, l, lds, it, lane, wave); __syncthreads();
#endif
            } else gla_item<true>(a, l, lds, it - 256, tid, lane, wave); }
            SEAM(PH_MIXB); }
        if (RUN(PH_GLU)) REP(PH_GLU) { PH_LOCALS
            pg8::StdSched S; S.init(ws + WS_YS5, ws + WS_WGLUT, T, 512, 256, 256, 256, G, bx);
            pg8::EpiGLU E{BR, DM, 256, nullptr, 1};
            pg8::gemm_phase(ldsl, 256, 256, S, E); SEAM(PH_GLU); }
        if (RUN(PH_GATE)) REP(PH_GATE) { PH_LOCALS
            pg8::StdSched S; S.init(HB, ws + WS_WGT, T, 4096, DM, DM, DM, G, bx);
            pg8::EpiProj E{(bf16_t*)(ws + WS_G), 4096, 4096, rowsq + (size_t)(l * 3 + 1) * T, 2};
            pg8::gemm_phase(ldsl, DM, DM, S, E); SEAM(PH_GATE); }
        if (RUN(PH_PB0)) { PH_LOCALS
            pg8::PbSched S; S.init(BR, ws + WS_WBT, G, bx);
            pg8::EpiPb E{MX, (bf16_t*)(ws + WS_G), -1};
            pg8::gemm_phase(ldsl, DM, DM, S, E); SEAM(PH_PB0); }
        if (RUN(PH_WOUT)) REP(PH_WOUT) { PH_LOCALS
            pg8::StdSched S; S.init(MX, ws + WS_WOT, T, DM, DM, DM, DM, G, bx);
            pg8::EpiResid E{a.out, a.out, (bf16_t*)(ws + WS_HB2), rowsq + (size_t)(l * 3 + 2) * T, 1.0f};
            pg8::gemm_phase(ldsl, DM, DM, S, E); SEAM(PH_WOUT); }
        if (RUN(PH_FFN2A)) REP(PH_FFN2A) { PH_LOCALS
            pg8::StdSched S; S.init(ws + WS_HB2, ws + WS_W3T, T, 2 * FF, DM, DM, DM, G, bx);
            pg8::EpiGLU E{ACT, FF, 0, rowsq + (size_t)(l * 3 + 2) * T, 0};
            pg8::gemm_phase(ldsl, DM, DM, S, E); SEAM(PH_FFN2A); }
        if (RUN(PH_FFN2B)) REP(PH_FFN2B) { PH_LOCALS
            pg8::StdSched S; S.init(ACT, ws + WS_W4T, T, DM, FF, FF, FF, G, bx);
            pg8::EpiResid E{a.out, a.out, l == 0 ? HB : nullptr, l == 0 ? rowsq + (size_t)3 * T : nullptr, 0.5f};
            pg8::gemm_phase(ldsl, FF, FF, S, E); SEAM(PH_FFN2B); }
}

__global__ void __launch_bounds__(NTHR, 2) mega(Args a) {
    extern __shared__ __attribute__((aligned(16))) unsigned char lds_raw[];
    LAS unsigned char* ldsl = (LAS unsigned char*)lds_raw; char* lds = (char*)lds_raw;
    cg::grid_group grid = cg::this_grid();
    const int lo = a.ph_lo, hi = a.ph_hi;
    if (lo < 0) grid.sync();
    if (threadIdx.x == 0) { volatile LAS unsigned* st = (volatile LAS unsigned*)(ldsl + LDS_BARST); st[0] = 0u; st[1] = 0u;
        (void)xb_add(&((unsigned*)(a.ws + WS_BARW))[XB_XCNT(xb_xcc_id())], 1u); }
    __syncthreads();
    layer_body<0>(lo, hi, grid, ldsl, lds);
    layer_body<1>(lo, hi, grid, ldsl, lds);
}

extern "C" void kernel_launch(void* const* d_in, const int* in_sizes, int n_in, void* d_out, int out_size, void* d_ws, size_t ws_size, hipStream_t stream) {
    static int grid = 0;
    if (grid == 0) {
        if (n_in != 25 || in_sizes[0] != T * DM || out_size != T * DM || ws_size < WS_END) { fprintf(stderr, "kernel_launch: unexpected shapes (n_in %d, in0 %d, out %d, ws %zu < %zu)\n", n_in, n_in > 0 ? in_sizes[0] : -1, out_size, ws_size, (size_t)WS_END); grid = -1; return; }
        int dev = 0, cus = 0, per_cu = 0;
        (void)hipGetDevice(&dev); (void)hipDeviceGetAttribute(&cus, hipDeviceAttributeMultiprocessorCount, dev);
        if (hipFuncSetAttribute((const void*)mega, hipFuncAttributeMaxDynamicSharedMemorySize, LDS_BYTES) != hipSuccess) { fprintf(stderr, "kernel_launch: hipFuncSetAttribute failed\n"); grid = -1; return; }
        if (hipOccupancyMaxActiveBlocksPerMultiprocessor(&per_cu, (const void*)mega, NTHR, LDS_BYTES) != hipSuccess || per_cu < 1) { fprintf(stderr, "kernel_launch: occupancy query says %d\n", per_cu); per_cu = 1; }
        (void)hipGetLastError();
        grid = cus * per_cu;
    }
    if (grid < 0) return;
    Args a{};
    for (int i = 0; i < 25; ++i) a.in[i] = (const float*)d_in[i];
    a.out = (float*)d_out; a.ws = (unsigned char*)d_ws; a.ph_lo = 0; a.ph_hi = N_PHASES;
#if defined(MK_PER_PHASE)
    for (int ph = 0; ph < N_PHASES; ++ph) { a.ph_lo = ph; a.ph_hi = ph + 1; hipLaunchKernelGGL(mega, dim3(grid), dim3(NTHR), LDS_BYTES, stream, a); }
    hipError_t e = hipPeekAtLastError();
#else
    (void)hipMemsetAsync((char*)d_ws + WS_BARW, 0, (XCD_BAR_WORDS + 64) * 4, stream);
    void* args[] = {&a};
    hipError_t e = hipLaunchCooperativeKernel((const void*)mega, dim3(grid), dim3(NTHR), args, LDS_BYTES, stream);
#endif
    if (e != hipSuccess) fprintf(stderr, "kernel_launch: cooperative launch failed: %s (grid %d)\n", hipGetErrorString(e), grid);
}
```

```cpp
#include <hip/hip_runtime.h>
#include <hip/hip_cooperative_groups.h>
#include <cstdio>
#include <cstdint>
namespace cg = cooperative_groups;

#define LAS __attribute__((address_space(3)))
typedef unsigned short bf16_t;
typedef short bf16x8 __attribute__((ext_vector_type(8)));
typedef float f32x4 __attribute__((ext_vector_type(4)));
typedef float f32x2 __attribute__((ext_vector_type(2)));
typedef unsigned u32x4 __attribute__((ext_vector_type(4)));
typedef unsigned u32x2 __attribute__((ext_vector_type(2)));

constexpr int T = 16384, DM = 1024, FF = 2816, SEQ = 8192;
constexpr int PP = 2816;
constexpr int C_SBQ = 0, C_SBK = 256, C_SBV = 512, C_S5U = 768, C_GQ = 1024, C_GK = 1152, C_GV = 1280, C_GR = 1536, C_GG = 1792,
              C_DQ = 1808, C_DK = 2064, C_DV = 2320, C_GATE = 2576, IN_W = 6672;
constexpr float EPS = 1e-6f;
constexpr int NTHR = 512, NWAVES = 8;
constexpr int LDS_BYTES = 135168;

constexpr size_t MiB = 1u << 20;
constexpr size_t WS_W1T = 0, WS_W2T = 11 * MiB, WS_WPT = 16 * MiB + 512 * 1024, WS_WGT = 22 * MiB, WS_WBT = 30 * MiB, WS_WOT = 32 * MiB,
                 WS_W3T = 34 * MiB, WS_W4T = 45 * MiB, WS_WGLUT = 50 * MiB + 512 * 1024;
constexpr size_t WS_HB = 51 * MiB;
constexpr size_t WS_MIX = WS_HB;
constexpr size_t WS_BR = 83 * MiB;
constexpr size_t WS_HB2 = WS_BR;
constexpr size_t WS_ACT = 115 * MiB;
constexpr size_t WS_G = WS_ACT;
constexpr size_t WS_TAIL = WS_ACT + 88 * MiB;
constexpr size_t WS_YS5 = WS_TAIL;
constexpr size_t WS_GSL = WS_YS5 + 8 * MiB;
constexpr size_t WS_GSI = WS_GSL + 8 * MiB;
constexpr size_t WS_S5E = WS_GSI + 8 * MiB;
constexpr size_t WS_S5C = WS_S5E + 2 * MiB;
constexpr size_t WS_MISC = 243 * MiB;
constexpr size_t WS_ROWSQ = WS_MISC;
constexpr size_t WS_ROPE = WS_MISC + 512 * 1024;
constexpr size_t WS_S5P = WS_ROPE + 2 * MiB;
constexpr size_t WS_GBL = WS_S5P + 512 * 1024;
constexpr size_t WS_BARW = WS_GBL + 512 * 1024;
constexpr size_t WS_END = WS_GBL + 1 * MiB;

typedef __bf16 bf16x2_t __attribute__((ext_vector_type(2)));
__device__ __forceinline__ unsigned cvt_pk_bf16(float lo, float hi) { f32x2 v = {lo, hi}; bf16x2_t b = __builtin_convertvector(v, bf16x2_t); return __builtin_bit_cast(unsigned, b); }
__device__ __forceinline__ float bflo(unsigned u) { return __uint_as_float(u << 16); }
__device__ __forceinline__ float bfhi(unsigned u) { return __uint_as_float(u & 0xffff0000u); }
__device__ __forceinline__ float bf1(bf16_t h) { return __uint_as_float(((unsigned)h) << 16); }
__device__ __forceinline__ bf16_t f2bf(float f) { return (bf16_t)(cvt_pk_bf16(f, 0.f) & 0xffffu); }
__device__ __forceinline__ u32x4 pack8(f32x4 a, f32x4 b) { u32x4 w; w.x = cvt_pk_bf16(a[0], a[1]); w.y = cvt_pk_bf16(a[2], a[3]); w.z = cvt_pk_bf16(b[0], b[1]); w.w = cvt_pk_bf16(b[2], b[3]); return w; }
__device__ __forceinline__ void unpack8(u32x4 w, float* f) { f[0] = bflo(w.x); f[1] = bfhi(w.x); f[2] = bflo(w.y); f[3] = bfhi(w.y); f[4] = bflo(w.z); f[5] = bfhi(w.z); f[6] = bflo(w.w); f[7] = bfhi(w.w); }
__device__ __forceinline__ float sigmoidf_(float x) { return __builtin_amdgcn_rcpf(1.f + __expf(-x)); }
#define LDS_WAIT() asm volatile("s_waitcnt lgkmcnt(0)" ::: "memory")

namespace pg8 {
constexpr int BM = 256, BK = 64, HALF = 128, HTB = HALF * BK * 2, NXCD = 8, WGM = 8;
__host__ __device__ __forceinline__ int lds_byte(int r, int c) { const int st = (r >> 4) * 2 + (c >> 5), rr = r & 15, cc = c & 31, ob = rr * 64 + cc * 2; return st * 1024 + (ob ^ (((ob >> 9) & 1) << 5)); }
__host__ __device__ __forceinline__ void stage_rc(int b, int& R, int& C) { const int st = b / 1024, sb = b % 1024, swz = sb ^ (((sb >> 9) & 1) << 5); R = (st >> 1) * 16 + swz / 64; C = (st & 1) * 32 + (swz % 64) / 2; }
__host__ __device__ __forceinline__ int perm32(int rho) { const int n = rho >> 4, i = rho & 15; return 8 * (i >> 2) + 4 * n + (i & 3); }
struct Unit { int pm, pn, kind; };

__device__ __forceinline__ void tile_map(int L, int nM, int nN, int& pm, int& pn) {
    const int nwg = nM * nN; int wgid = L;
    { const int q = nwg / NXCD, r = nwg % NXCD, xcd = wgid % NXCD, off = wgid / NXCD; wgid = (xcd < r ? xcd * (q + 1) : r * (q + 1) + (xcd - r) * q) + off; }
    const int nig = WGM * nN, gid = wgid / nig, fm = gid * WGM, gsz = (nM - fm) < WGM ? (nM - fm) : WGM;
    pm = fm + ((wgid % nig) % gsz); pn = (wgid % nig) / gsz;
}
struct StdSched {
    const char* A; const char* Bt; size_t tsA, tsB; int ntk; int nM, nN, nwg, G, c;
    __device__ __forceinline__ void init(const void* A_, const void* Bt_, int M, int N, int K, int lda, int ldb, int G_, int c_) {
        A = (const char*)A_; Bt = (const char*)Bt_; tsA = (size_t)BM * lda * 2; tsB = (size_t)BM * ldb * 2; ntk = K / BK; nM = M / BM; nN = N / BM; nwg = nM * nN; G = G_; c = c_; }
    __device__ __forceinline__ bool next(int i, Unit& u) const { const long L = (long)i * G + c; if (L >= nwg) return false; tile_map((int)L, nM, nN, u.pm, u.pn); u.kind = 0; return true; }
    __device__ __forceinline__ const char* pa(const Unit& u) const { return A + (size_t)u.pm * tsA; }
    __device__ __forceinline__ const char* pb(const Unit& u) const { return Bt + (size_t)u.pn * tsB; }
    __device__ __forceinline__ int nt(const Unit&) const { return ntk; }
};
struct PbSched {
    const char* A; const char* Bt; int G, c;
    __device__ __forceinline__ void init(const void* A_, const void* Bt_, int G_, int c_) { A = (const char*)A_; Bt = (const char*)Bt_; G = G_; c = c_; }
    __device__ __forceinline__ bool next(int i, Unit& u) const { const long L = (long)(i >> 2) * G + c; if (L >= 256) return false; tile_map((int)L, 64, 4, u.pm, u.pn); u.kind = i & 3; return true; }
    __device__ __forceinline__ const char* pa(const Unit& u) const { return A + (size_t)u.pm * (256 * 1024 * 2) + u.kind * 512; }
    __device__ __forceinline__ const char* pb(const Unit& u) const { return Bt + (size_t)u.pn * (256 * 1024 * 2) + u.kind * 512; }
    __device__ __forceinline__ int nt(const Unit&) const { return 4; }
};

template <class Epi, class Sched>
__device__ __forceinline__ void gemm_phase(LAS unsigned char* lds, int lda, int ldb, const Sched& S, const Epi& E) {
    const int tid = threadIdx.x, wid = __builtin_amdgcn_readfirstlane(tid >> 6), lane = tid & 63, wr = wid >> 2, wc = wid & 3, fr = lane & 15, fq = lane >> 4;
    unsigned voffA[2], voffB[2];
#pragma unroll
    for (int i = 0; i < 2; ++i) { int R, C; stage_rc(tid * 16 + i * 8192, R, C); const int Rb = (R & ~31) + perm32(R & 31);
        voffA[i] = (unsigned)(R * lda + C) * 2u; voffB[i] = (unsigned)(Rb * ldb + C) * 2u; }
    const size_t kstep = (size_t)(BK * 2);
    const size_t hsA = (size_t)HALF * lda * 2, hsB = (size_t)HALF * ldb * 2;
    const unsigned ldsw = (unsigned)wid * 1024u;
    const int aoff = lds_byte(wr * 64 + fr, fq * 8), boff = lds_byte(wc * 32 + fr, fq * 8);
#define PG8_SA(b, h) (((b) * 2 + (h)) * HTB)
#define PG8_SB(b, h) ((4 + (b) * 2 + (h)) * HTB)
#define PG8_STAGE(bufoff, gbase, voff) do { _Pragma("unroll") for (int _i = 0; _i < 2; ++_i) \
        __builtin_amdgcn_global_load_lds((const unsigned*)((const char*)(gbase) + (voff)[_i]), (LAS unsigned*)(lds + (bufoff) + ldsw + _i * 8192), 16, 0, 0); } while (0)
#define PG8_LDA(dst, b, h) do { _Pragma("unroll") for (int m = 0; m < 4; ++m) _Pragma("unroll") for (int k = 0; k < 2; ++k) dst[m][k] = *(const LAS bf16x8*)(lds + PG8_SA(b, h) + aoff + m * 2048 + k * 1024); } while (0)
#define PG8_LDB(dst, b, h) do { _Pragma("unroll") for (int n = 0; n < 2; ++n) _Pragma("unroll") for (int k = 0; k < 2; ++k) dst[n][k] = *(const LAS bf16x8*)(lds + PG8_SB(b, h) + boff + n * 2048 + k * 1024); } while (0)
#define PG8_MMA(ai, bj, At, Bt) do { __builtin_amdgcn_s_setprio(1); _Pragma("unroll") for (int m = 0; m < 4; ++m) _Pragma("unroll") for (int n = 0; n < 2; ++n) _Pragma("unroll") for (int k = 0; k < 2; ++k) \
        acc[ai][bj][m][n] = __builtin_amdgcn_mfma_f32_16x16x32_bf16(Bt[n][k], At[m][k], acc[ai][bj][m][n], 0, 0, 0); __builtin_amdgcn_s_setprio(0); } while (0)
#define PG8_WAIT_V(n) asm volatile("s_waitcnt vmcnt(" #n ")" ::: "memory")
#define PG8_WAIT_L(n) asm volatile("s_waitcnt lgkmcnt(" #n ")" ::: "memory")
#define PG8_BAR __builtin_amdgcn_s_barrier()
#define PG8_SCHED __builtin_amdgcn_sched_barrier(0)
    Unit cur, nxt; int ui = 0;
    if (!S.next(0, cur)) return;
    f32x4 acc[2][2][4][2];
#pragma unroll
    for (int a = 0; a < 2; ++a)
#pragma unroll
        for (int b = 0; b < 2; ++b)
#pragma unroll
            for (int m = 0; m < 4; ++m)
#pragma unroll
                for (int n = 0; n < 2; ++n) acc[a][b][m][n] = (f32x4){0.f, 0.f, 0.f, 0.f};
    bf16x8 At[4][2], B0[2][2], B1[2][2];
    const char* cA = S.pa(cur); const char* cB = S.pb(cur);
    {
        PG8_STAGE(PG8_SB(0, 0), cB, voffB); PG8_STAGE(PG8_SB(0, 1), cB + hsB, voffB); PG8_STAGE(PG8_SA(0, 0), cA, voffA); PG8_STAGE(PG8_SA(0, 1), cA + hsA, voffA);
        if (wr == 1) PG8_BAR;
        PG8_WAIT_V(2); PG8_BAR;
        PG8_STAGE(PG8_SB(1, 0), cB + kstep, voffB); PG8_STAGE(PG8_SA(1, 0), cA + kstep, voffA); PG8_STAGE(PG8_SB(1, 1), cB + hsB + kstep, voffB);
        PG8_WAIT_V(6); PG8_BAR;
    }
    for (;;) {
        const bool has_next = S.next(ui + 1, nxt);
        const char* nA = has_next ? S.pa(nxt) : cA; const char* nB = has_next ? S.pb(nxt) : cB;
        const int nt = S.nt(cur);
        for (int t = 0; t < nt; t += 2) {
            const bool last = (t == nt - 2);
            const char* a1 = cA + (size_t)(t + 1) * kstep;
            const char* a2 = last ? nA : cA + (size_t)(t + 2) * kstep; const char* b2 = last ? nB : cB + (size_t)(t + 2) * kstep;
            const char* a3 = a2 + kstep; const char* b3 = b2 + kstep;
            PG8_LDB(B0, 0, 0); PG8_LDB(B1, 0, 1); PG8_SCHED; PG8_LDA(At, 0, 0); PG8_STAGE(PG8_SA(1, 1), a1 + hsA, voffA);
            PG8_WAIT_V(8); PG8_WAIT_L(0); PG8_BAR; PG8_MMA(0, 0, At, B0); PG8_MMA(0, 1, At, B1); PG8_BAR; PG8_SCHED;
            PG8_LDA(At, 0, 1); PG8_STAGE(PG8_SB(0, 0), b2, voffB); PG8_STAGE(PG8_SB(0, 1), b2 + hsB, voffB); PG8_STAGE(PG8_SA(0, 0), a2, voffA);
            PG8_WAIT_V(8); PG8_WAIT_L(0); PG8_BAR; PG8_MMA(1, 0, At, B0); PG8_MMA(1, 1, At, B1); PG8_BAR; PG8_SCHED;
            PG8_LDB(B0, 1, 0); PG8_LDB(B1, 1, 1); PG8_SCHED; PG8_LDA(At, 1, 0); PG8_STAGE(PG8_SA(0, 1), a2 + hsA, voffA);
            PG8_WAIT_V(8); PG8_WAIT_L(0); PG8_BAR; PG8_MMA(0, 0, At, B0); PG8_MMA(0, 1, At, B1); PG8_BAR; PG8_SCHED;
            PG8_LDA(At, 1, 1); PG8_STAGE(PG8_SB(1, 0), b3, voffB); PG8_STAGE(PG8_SB(1, 1), b3 + hsB, voffB); PG8_STAGE(PG8_SA(1, 0), a3, voffA);
            PG8_WAIT_V(8); PG8_WAIT_L(0); PG8_BAR; PG8_MMA(1, 0, At, B0); PG8_MMA(1, 1, At, B1); PG8_BAR; PG8_SCHED;
        }
        if (wr == 0) PG8_BAR;
        E(acc, cur, wr, wc, fr, fq);
        if (!has_next) break;
#pragma unroll
        for (int a = 0; a < 2; ++a)
#pragma unroll
            for (int b = 0; b < 2; ++b)
#pragma unroll
                for (int m = 0; m < 4; ++m)
#pragma unroll
                    for (int n = 0; n < 2; ++n) acc[a][b][m][n] = (f32x4){0.f, 0.f, 0.f, 0.f};
        cur = nxt; cA = nA; cB = nB; ++ui;
        if (wr == 1) PG8_BAR;
    }
    PG8_WAIT_V(0);
    PG8_BAR;
#undef PG8_SA
#undef PG8_SB
#undef PG8_STAGE
#undef PG8_LDA
#undef PG8_LDB
#undef PG8_MMA
#undef PG8_WAIT_V
#undef PG8_WAIT_L
#undef PG8_BAR
#undef PG8_SCHED
}

struct EpiGLU {
    bf16_t* O; int ldc; int coff; const float* rowsq; int mode;
    __device__ __forceinline__ void operator()(const f32x4 (&acc)[2][2][4][2], const Unit& u, int wr, int wc, int fr, int fq) const {
        const int row0 = u.pm * BM + wr * 64 + fr, col0 = coff + u.pn * 128 + wc * 32 + 8 * fq;
#pragma unroll
        for (int ai = 0; ai < 2; ++ai)
#pragma unroll
            for (int m = 0; m < 4; ++m) {
                const int r = row0 + ai * HALF + m * 16;
                float rs = 1.f; if (mode == 0) rs = rsqrtf(rowsq[r] * (1.f / 1024.f) + EPS);
                f32x4 o[2];
#pragma unroll
                for (int n = 0; n < 2; ++n)
#pragma unroll
                    for (int j = 0; j < 4; ++j) { const float a = acc[ai][0][m][n][j] * rs, b = acc[ai][1][m][n][j] * rs;
                        o[n][j] = (mode == 0) ? a * b * sigmoidf_(a) : a * sigmoidf_(b); }
                *(u32x4*)(O + (size_t)r * ldc + col0) = pack8(o[0], o[1]);
            }
    }
};
struct EpiResid {
    const float* Hin; float* Hout; bf16_t* HBo; float* rsn; float scale;
    __device__ __forceinline__ void operator()(const f32x4 (&acc)[2][2][4][2], const Unit& u, int wr, int wc, int fr, int fq) const {
        const int row0 = u.pm * BM + wr * 64 + fr, col0 = u.pn * BM + wc * 32 + 8 * fq;
#pragma unroll
        for (int ai = 0; ai < 2; ++ai)
#pragma unroll
            for (int m = 0; m < 4; ++m) {
                const int r = row0 + ai * HALF + m * 16; float ss = 0.f;
#pragma unroll
                for (int bj = 0; bj < 2; ++bj) { const size_t off = (size_t)r * DM + col0 + bj * HALF;
                    f32x4 h0 = *(const f32x4*)(Hin + off), h1 = *(const f32x4*)(Hin + off + 4);
                    h0 = h0 + acc[ai][bj][m][0] * scale; h1 = h1 + acc[ai][bj][m][1] * scale;
                    *(f32x4*)(Hout + off) = h0; *(f32x4*)(Hout + off + 4) = h1;
                    if (HBo) *(u32x4*)(HBo + off) = pack8(h0, h1);
                    ss += h0[0] * h0[0] + h0[1] * h0[1] + h0[2] * h0[2] + h0[3] * h0[3] + h1[0] * h1[0] + h1[1] * h1[1] + h1[2] * h1[2] + h1[3] * h1[3]; }
                if (rsn) { ss += __shfl_xor(ss, 16); ss += __shfl_xor(ss, 32); if (fq == 0) atomicAdd(rsn + r, ss); }
                __builtin_amdgcn_sched_barrier(0);
            }
    }
};
struct EpiProj {
    bf16_t* O; int ldc; int ncols; const float* rowsq; int act;
    __device__ __forceinline__ void operator()(const f32x4 (&acc)[2][2][4][2], const Unit& u, int wr, int wc, int fr, int fq) const {
        const int row0 = u.pm * BM + wr * 64 + fr, col0 = u.pn * BM + wc * 32 + 8 * fq;
#pragma unroll
        for (int ai = 0; ai < 2; ++ai)
#pragma unroll
            for (int m = 0; m < 4; ++m) {
                const int r = row0 + ai * HALF + m * 16; const float rs = rsqrtf(rowsq[r] * (1.f / 1024.f) + EPS);
#pragma unroll
                for (int bj = 0; bj < 2; ++bj) { const int c = col0 + bj * HALF;
                    if (c < ncols) { f32x4 v0 = acc[ai][bj][m][0] * rs, v1 = acc[ai][bj][m][1] * rs;
                        if (act == 2) {
#pragma unroll
                            for (int j = 0; j < 4; ++j) { v0[j] = sigmoidf_(v0[j]); v1[j] = sigmoidf_(v1[j]); }
                            *((u32x4*)O + ((size_t)((u.pm * 16 + u.pn) * 16 + (ai * 4 + m) * 2 + bj)) * NTHR + threadIdx.x) = pack8(v0, v1); continue; }
                        if (act) {
#pragma unroll
                            for (int j = 0; j < 4; ++j) { v0[j] = sigmoidf_(v0[j]); v1[j] = sigmoidf_(v1[j]); } }
                        *(u32x4*)(O + (size_t)r * ldc + c) = pack8(v0, v1); } }
            }
    }
};
struct EpiPb {
    bf16_t* MX; const bf16_t* Gt; int n_;
    __device__ __forceinline__ void operator()(const f32x4 (&acc)[2][2][4][2], const Unit& u, int wr, int wc, int fr, int fq) const {
        int row0 = u.pm * BM + wr * 64 + fr, col0 = u.pn * BM + wc * 32 + 8 * fq; const int n = (n_ < 0) ? u.kind : n_;
        int tl = threadIdx.x; asm volatile("" : "+v"(tl), "+v"(row0));
#pragma unroll
        for (int ai = 0; ai < 2; ++ai)
#pragma unroll
            for (int m = 0; m < 4; ++m) {
                const int r = row0 + ai * HALF + m * 16;
#pragma unroll
                for (int bj = 0; bj < 2; ++bj) { const int c = col0 + bj * HALF;
                    float g[8]; unpack8(*((const u32x4*)Gt + ((size_t)((u.pm * 16 + n * 4 + u.pn) * 16 + (ai * 4 + m) * 2 + bj)) * NTHR + tl), g); f32x4 p0, p1;
#pragma unroll
                    for (int j = 0; j < 4; ++j) { p0[j] = g[j] * acc[ai][bj][m][0][j]; p1[j] = g[4 + j] * acc[ai][bj][m][1][j]; }
                    bf16_t* mp = MX + (size_t)r * DM + c;
                    if (n > 0) { float o[8]; unpack8(*(const u32x4*)mp, o);
#pragma unroll
                        for (int j = 0; j < 4; ++j) { p0[j] += o[j]; p1[j] += o[4 + j]; } }
                    *(u32x4*)mp = pack8(p0, p1); }
                __builtin_amdgcn_sched_barrier(0);
            }
    }
};
}

struct Args { const float* in[25]; float* out; unsigned char* ws; int ph_lo, ph_hi; };

__device__ __forceinline__ void tr_item(const float* W, int ldn, int col0, const float* gain, bf16_t* WT, int ldk, int koff, int halfn, int nblk, float* scr, int item, int lane) {
    const int kb = item / nblk, nb = item % nblk, k0 = 64 * kb, n0 = 64 * nb;
    const int n4 = (lane & 15) * 4, kq = lane >> 4;
    f32x4 v[16];
#pragma unroll
    for (int i = 0; i < 16; ++i) v[i] = *(const f32x4*)(W + (size_t)(k0 + 4 * i + kq) * ldn + col0 + n0 + n4);
#pragma unroll
    for (int i = 0; i < 16; ++i) { const int kk = 4 * i + kq; const float gv = gain ? gain[k0 + kk] : 1.f; float* d = scr + kk * 65 + n4;
        d[0] = v[i][0] * gv; d[1] = v[i][1] * gv; d[2] = v[i][2] * gv; d[3] = v[i][3] * gv; }
    LDS_WAIT();
    int rbase = n0;
    if (halfn) { const int half = n0 / halfn, ff = n0 % halfn; rbase = (ff / 128) * 256 + half * 128 + (ff % 128); }
    const int c = lane & 7;
#pragma unroll
    for (int j = 0; j < 8; ++j) { const int n = (lane >> 3) + 8 * j; const float* s = scr + (8 * c) * 65 + n;
        u32x4 o; o.x = cvt_pk_bf16(s[0 * 65], s[1 * 65]); o.y = cvt_pk_bf16(s[2 * 65], s[3 * 65]); o.z = cvt_pk_bf16(s[4 * 65], s[5 * 65]); o.w = cvt_pk_bf16(s[6 * 65], s[7 * 65]);
        *(u32x4*)(WT + (size_t)(rbase + n) * ldk + koff + k0 + 8 * c) = o; }
    LDS_WAIT();
}

__device__ __forceinline__ float wave_sum(float v) {
#pragma unroll
    for (int o = 1; o < 64; o <<= 1) v += __shfl_xor(v, o);
    return v;
}

__device__ __forceinline__ void phase_convert(const Args& a, int l, char* lds, int gw, int NGW, int lane, int wave) {
    unsigned char* ws = a.ws;
    float* scr = (float*)(lds + wave * 16640);
    const float* W1 = a.in[2] + (size_t)l * DM * 2 * FF; const float* W2 = a.in[3] + (size_t)l * FF * DM;
    const float* WIN = a.in[5] + (size_t)l * DM * IN_W;
    const float* WBR = a.in[20] + (size_t)l * 4 * 256 * DM; const float* WO = a.in[21] + (size_t)l * DM * DM;
    const float* W3 = a.in[23] + (size_t)l * DM * 2 * FF; const float* W4 = a.in[24] + (size_t)l * FF * DM;
    const float* WGLU = a.in[14] + (size_t)l * 256 * 512;
    const float* g1 = a.in[1] + l * DM; const float* gm = a.in[4] + l * DM; const float* g2 = a.in[22] + l * DM;
    constexpr int I1 = 16 * 88, I2 = 44 * 16, IP = 16 * 41, IG = 16 * 64, IB = 4 * 4 * 16, IO = 16 * 16, IGL = 4 * 8;
    int off = 0;
#define CONV_LOOP(I, CALL) { int g0 = gw - off; if (g0 < 0) g0 += NGW; for (int r = g0; r < (I); r += NGW) { CALL; } off = (off + (I)) % NGW; }
    CONV_LOOP(I1, tr_item(W1, 2 * FF, 0, g1, (bf16_t*)(ws + WS_W1T), DM, 0, FF, 88, scr, r, lane))
    CONV_LOOP(I2, tr_item(W2, DM, 0, nullptr, (bf16_t*)(ws + WS_W2T), FF, 0, 0, 16, scr, r, lane))
    CONV_LOOP(IP, tr_item(WIN, IN_W, 0, gm, (bf16_t*)(ws + WS_WPT), DM, 0, 0, 41, scr, r, lane))
    CONV_LOOP(IG, tr_item(WIN, IN_W, C_GATE, gm, (bf16_t*)(ws + WS_WGT), DM, 0, 0, 64, scr, r, lane))
    CONV_LOOP(IB, tr_item(WBR + (size_t)(r / 64) * 256 * DM, DM, 0, nullptr, (bf16_t*)(ws + WS_WBT), DM, (r / 64) * 256, 0, 16, scr, r % 64, lane))
    CONV_LOOP(IO, tr_item(WO, DM, 0, nullptr, (bf16_t*)(ws + WS_WOT), DM, 0, 0, 16, scr, r, lane))
    CONV_LOOP(I1, tr_item(W3, 2 * FF, 0, g2, (bf16_t*)(ws + WS_W3T), DM, 0, FF, 88, scr, r, lane))
    CONV_LOOP(I2, tr_item(W4, DM, 0, nullptr, (bf16_t*)(ws + WS_W4T), FF, 0, 0, 16, scr, r, lane))
    CONV_LOOP(IGL, tr_item(WGLU, 512, 0, nullptr, (bf16_t*)(ws + WS_WGLUT), 256, 0, 256, 8, scr, r, lane))
    { u32x4* z = (u32x4*)(ws + WS_WPT + (size_t)2624 * DM * 2); const int nz = 192 * DM * 2 / 16;
      for (int i = gw * 64 + lane; i < nz; i += NGW * 64) z[i] = (u32x4){0u, 0u, 0u, 0u}; }
    { const int gi = gw * 64 + lane;
      if (gi < 1024) { const int g = gi >> 6;
          const float lr = a.in[6][l * 1024 + gi], li = a.in[7][l * 1024 + gi]; const float dt = expf(a.in[8][l * 16 + g]);
          const float er = expf(lr * dt); float sn, cs; sincosf(li * dt, &sn, &cs);
          const float br = er * cs, bi = er * sn;
          const float nr = br - 1.f, ni = bi, den = lr * lr + li * li;
          const float fr = (nr * lr + ni * li) / den, fi = (ni * lr - nr * li) / den;
          f32x2* lamb = (f32x2*)(ws + WS_S5P); f32x2* lam64 = (f32x2*)(ws + WS_S5P + 8192);
          f32x2* bbar = (f32x2*)(ws + WS_S5P + 16384); float* ct = (float*)(ws + WS_S5P + 16384 + 131072);
          lamb[gi] = (f32x2){br, bi};
          float pr = br, pi = bi;
#pragma unroll
          for (int s = 0; s < 6; ++s) { const float tr = pr * pr - pi * pi, ti = 2.f * pr * pi; pr = tr; pi = ti; }
          lam64[gi] = (f32x2){pr, pi};
          const float* bre = a.in[9] + (size_t)l * 16384 + (size_t)gi * 16; const float* bim = a.in[10] + (size_t)l * 16384 + (size_t)gi * 16;
          for (int h = 0; h < 16; ++h) { const float xr = bre[h], xi = bim[h]; bbar[((gi >> 6) * 16 + h) * 64 + (gi & 63)] = (f32x2){fr * xr - fi * xi, fr * xi + fi * xr}; }
          const int p = gi & 63;
          const float* cre = a.in[11] + (size_t)l * 16384 + (size_t)g * 1024; const float* cim = a.in[12] + (size_t)l * 16384 + (size_t)g * 1024;
          for (int h = 0; h < 16; ++h) { ct[gi * 32 + h] = cre[h * 64 + p]; ct[gi * 32 + 16 + h] = cim[h * 64 + p]; }
      } }
    if (l == 0) {
        { float* rq = (float*)(ws + WS_ROWSQ); for (int i = gw * 64 + lane; i < 5 * T; i += NGW * 64) rq[T + i] = 0.f; }
        { float* cs = (float*)(ws + WS_ROPE); float* sn = cs + SEQ * 32;
          for (int i = gw * 64 + lane; i < SEQ * 32; i += NGW * 64) { const int pos = i >> 5, j = i & 31;
              const float inv = powf(10000.f, -(float)(2 * j) / 64.f); const float ang = (float)pos * inv; float s, c; sincosf(ang, &s, &c); cs[i] = c; sn[i] = s; } }
        { const float* x = a.in[0]; bf16_t* hb = (bf16_t*)(ws + WS_HB); float* rq = (float*)(ws + WS_ROWSQ);
          for (int m = gw; m < T; m += NGW) { const f32x4* xr = (const f32x4*)(x + (size_t)m * DM) + lane; float s = 0.f; f32x4 v[4];
#pragma unroll
              for (int j = 0; j < 4; ++j) { v[j] = xr[64 * j]; s += v[j][0] * v[j][0] + v[j][1] * v[j][1] + v[j][2] * v[j][2] + v[j][3] * v[j][3]; }
              s = wave_sum(s); if (lane == 0) rq[m] = s;
              u32x2* o = (u32x2*)(hb + (size_t)m * DM) + lane;
#pragma unroll
              for (int j = 0; j < 4; ++j) o[64 * j] = (u32x2){cvt_pk_bf16(v[j][0], v[j][1]), cvt_pk_bf16(v[j][2], v[j][3])}; } }
    }
}

__device__ __forceinline__ bf16x8 ldfrag(const char* base, int row, int pitch, int k0, int lane) {
    return *(const bf16x8*)(base + ((size_t)(row + (lane & 15)) * pitch + k0 + (lane >> 4) * 8) * 2);
}
#define MFMA16(a, b, c) __builtin_amdgcn_mfma_f32_16x16x32_bf16((a), (b), (c), 0, 0, 0)

__device__ __forceinline__ void dsa_rope_phase(const Args& a, int l, int gw, int NGW, int lane) {
    bf16_t* proj = (bf16_t*)(a.ws + WS_ACT); const float* cs = (const float*)(a.ws + WS_ROPE); const float* sn = cs + SEQ * 32;
    const float* qn = a.in[18] + l * 64; const float* kn = a.in[19] + l * 64;
    const int l32 = lane & 31, vec = l32 >> 2, j = l32 & 3;
    const float* gsrc = (vec < 4) ? qn : kn;
    float ga[8], gb[8];
#pragma unroll
    for (int e = 0; e < 8; ++e) { ga[e] = gsrc[8 * j + e]; gb[e] = gsrc[32 + 8 * j + e]; }
    const float osc = (vec < 4) ? 0.125f : 1.f;
    const int col = (vec < 4) ? (C_DQ + vec * 64) : (C_DK + (vec - 4) * 64);
    for (int pair = gw; pair < T / 2; pair += NGW) {
        const int tok = 2 * pair + (lane >> 5); const int pos = tok & (SEQ - 1);
        bf16_t* p = proj + (size_t)tok * PP + col + 8 * j;
        float x1[8], x2[8]; unpack8(*(const u32x4*)p, x1); unpack8(*(const u32x4*)(p + 32), x2);
        float ss = 0.f;
#pragma unroll
        for (int e = 0; e < 8; ++e) ss += x1[e] * x1[e] + x2[e] * x2[e];
        ss += __shfl_xor(ss, 1); ss += __shfl_xor(ss, 2);
        const float ri = rsqrtf(ss * (1.f / 64.f) + EPS);
        const f32x4* cp = (const f32x4*)(cs + pos * 32 + 8 * j); const f32x4* sp = (const f32x4*)(sn + pos * 32 + 8 * j);
        const f32x4 c0 = cp[0], c1 = cp[1], s0 = sp[0], s1 = sp[1];
        f32x4 o1[2], o2[2];
#pragma unroll
        for (int e = 0; e < 8; ++e) { const float c = (e < 4) ? c0[e & 3] : c1[e & 3], s = (e < 4) ? s0[e & 3] : s1[e & 3];
            const float y1 = x1[e] * ri * ga[e], y2 = x2[e] * ri * gb[e];
            o1[e >> 2][e & 3] = (y1 * c - y2 * s) * osc; o2[e >> 2][e & 3] = (y2 * c + y1 * s) * osc; }
        *(u32x4*)p = pack8(o1[0], o1[1]); *(u32x4*)(p + 32) = pack8(o2[0], o2[1]);
    }
}

__device__ __forceinline__ void s5_load_u(const bf16_t* proj, int b, int c, int g, float* U, int lane) {
    const bf16_t* p = proj + (size_t)(b * SEQ + c * 64 + lane) * PP + C_S5U + g * 16;
    float f[16]; unpack8(*(const u32x4*)p, f); unpack8(*(const u32x4*)(p + 8), f + 8);
    f32x4* d = (f32x4*)(U + lane * 16);
#pragma unroll
    for (int i = 0; i < 4; ++i) d[i] = (f32x4){f[4 * i], f[4 * i + 1], f[4 * i + 2], f[4 * i + 3]};
    LDS_WAIT();
}

__device__ __forceinline__ void s5_pre_phase(const Args& a, char* lds, int gw, int NGW, int lane, int wave) {
    const bf16_t* proj = (const bf16_t*)(a.ws + WS_ACT);
    const f32x2* lamb = (const f32x2*)(a.ws + WS_S5P); const f32x2* bbar = (const f32x2*)(a.ws + WS_S5P + 16384);
    f32x2* E = (f32x2*)(a.ws + WS_S5E);
    float* U = (float*)(lds + wave * 12544); f32x2* BU = (f32x2*)(lds + wave * 12544 + 4096);
    const int i16 = lane & 15, kq = lane >> 4;
    for (int item = gw; item < 4096; item += NGW) {
        const int g = item & 15, c = (item >> 4) & 127, b = item >> 11;
        s5_load_u(proj, b, c, g, U, lane);
        const f32x2 lam = lamb[g * 64 + lane];
        f32x2 ab[4][4];
#pragma unroll
        for (int pt = 0; pt < 4; ++pt)
#pragma unroll
            for (int s2 = 0; s2 < 4; ++s2) ab[pt][s2] = bbar[(g * 16 + 4 * kq + s2) * 64 + pt * 16 + i16];
        float sr = 0.f, si = 0.f;
        for (int tb = 0; tb < 4; ++tb) {
            const f32x4 uv = *(const f32x4*)(U + (tb * 16 + i16) * 16 + 4 * kq);
#pragma unroll
            for (int pt = 0; pt < 4; ++pt) { f32x4 dr = {0.f, 0.f, 0.f, 0.f}, di = {0.f, 0.f, 0.f, 0.f};
#pragma unroll
                for (int s2 = 0; s2 < 4; ++s2) { dr = __builtin_amdgcn_mfma_f32_16x16x4f32(ab[pt][s2][0], uv[s2], dr, 0, 0, 0); di = __builtin_amdgcn_mfma_f32_16x16x4f32(ab[pt][s2][1], uv[s2], di, 0, 0, 0); }
#pragma unroll
                for (int j = 0; j < 4; ++j) BU[i16 * 66 + pt * 16 + kq * 4 + j] = (f32x2){dr[j], di[j]}; }
            LDS_WAIT();
#pragma unroll 4
            for (int tt = 0; tt < 16; ++tt) { const f32x2 v = BU[tt * 66 + lane];
                const float nr = lam[0] * sr - lam[1] * si + v[0], ni = lam[0] * si + lam[1] * sr + v[1]; sr = nr; si = ni; }
            LDS_WAIT();
        }
        E[(size_t)((b * 128 + c) * 16 + g) * 64 + lane] = (f32x2){sr, si};
        LDS_WAIT();
    }
}

constexpr int GL_LA = 0, GL_QE = 8448, GL_KE = GL_QE + 5120, GL_KDT = GL_KE + 5120, GL_VT = GL_KDT + 4608, GL_ATT = GL_VT + 9216, GL_SINT = GL_ATT + 9216, GL_OF = GL_SINT + 5120, GL_END = GL_OF + 16640;
template <bool MAIN>
__device__ __forceinline__ void gla_item(const Args& a, int l, char* lds, int item, int tid, int lane, int wave) {
    const int c = item & 127, h = (item >> 7) & 3, b = item >> 9;
    const bf16_t* proj = (const bf16_t*)(a.ws + WS_ACT);
    float* LA = (float*)(lds + GL_LA); bf16_t* QE = (bf16_t*)(lds + GL_QE); bf16_t* KE = (bf16_t*)(lds + GL_KE); bf16_t* KDT = (bf16_t*)(lds + GL_KDT);
    bf16_t* VT = (bf16_t*)(lds + GL_VT); bf16_t* ATT = (bf16_t*)(lds + GL_ATT); bf16_t* SINT = (bf16_t*)(lds + GL_SINT); float* OF = (float*)(lds + GL_OF);
    const int t = tid >> 3, dg = tid & 7; const size_t tok = (size_t)b * SEQ + c * 64 + t;
    const bf16_t* prow = proj + tok * PP;
    const u32x4 ld_g0 = *(const u32x4*)(prow + C_GG), ld_g1 = *(const u32x4*)(prow + C_GG + 8);
    const u32x2 ld_q = *(const u32x2*)(prow + C_GQ + h * 32 + dg * 4), ld_k = *(const u32x2*)(prow + C_GK + h * 32 + dg * 4);
    const u32x4 ld_v = *(const u32x4*)(prow + C_GV + h * 64 + dg * 8);
    u32x4 ld_r = {0u, 0u, 0u, 0u}; f32x4 ld_s = {0.f, 0.f, 0.f, 0.f};
    if (MAIN) { ld_r = *(const u32x4*)(prow + C_GR + h * 64 + dg * 8);
        ld_s = *(const f32x4*)((const float*)(a.ws + WS_GSI) + (size_t)((b * 4 + h) * 128 + c) * 2048 + tid * 4); }
    { float g1[16]; unpack8(ld_g0, g1); unpack8(ld_g1, g1 + 8);
      const float* wg = a.in[15] + (size_t)l * 16 * 128 + h * 32 + dg * 4; const float* bg = a.in[16] + l * 128 + h * 32 + dg * 4;
      f32x4 z4 = *(const f32x4*)bg;
#pragma unroll
      for (int r = 0; r < 16; ++r) z4 = z4 + *(const f32x4*)(wg + r * 128) * g1[r];
#pragma unroll
      for (int dd = 0; dd < 4; ++dd) { const float z = z4[dd];
          const float ls = fminf(z, 0.f) - log1pf(__expf(-fabsf(z)));
          LA[t * 33 + dg * 4 + dd] = ls * (1.f / 16.f); } }
    __syncthreads();
#pragma unroll
    for (int dd = 0; dd < 4; ++dd) { const int d = wave * 4 + dd; float v = LA[lane * 33 + d];
#pragma unroll
        for (int o = 1; o < 64; o <<= 1) { const float y = __shfl_up(v, o); if (lane >= o) v += y; }
        LA[lane * 33 + d] = v; }
    __syncthreads();
    { float q4[4], k4[4];
      { const u32x2 qv = ld_q; const u32x2 kv = ld_k;
        q4[0] = bflo(qv.x); q4[1] = bfhi(qv.x); q4[2] = bflo(qv.y); q4[3] = bfhi(qv.y); k4[0] = bflo(kv.x); k4[1] = bfhi(kv.x); k4[2] = bflo(kv.y); k4[3] = bfhi(kv.y); }
#pragma unroll
      for (int dd = 0; dd < 4; ++dd) { const int d = dg * 4 + dd; const float bc = LA[t * 33 + d], bl = LA[63 * 33 + d];
          if (MAIN) { QE[t * 40 + d] = f2bf(q4[dd] * __expf(bc) * 0.17677669529663687f); KE[t * 40 + d] = f2bf(k4[dd] * __expf(-bc)); }
          else KDT[d * 72 + t] = f2bf(k4[dd] * __expf(bl - bc)); }
      float v8[8]; unpack8(ld_v, v8);
#pragma unroll
      for (int e = 0; e < 8; ++e) VT[(dg * 8 + e) * 72 + t] = f2bf(v8[e]);
      if (MAIN) { const f32x4 sv = ld_s; const int d = (tid * 4) >> 6, e0 = (tid * 4) & 63;
#pragma unroll
          for (int i = 0; i < 4; ++i) SINT[(e0 + i) * 40 + d] = f2bf(sv[i]); } }
    __syncthreads();
    if (!MAIN) {
        const int dt = wave >> 2, et = wave & 3; f32x4 acc = {0.f, 0.f, 0.f, 0.f};
#pragma unroll
        for (int ks = 0; ks < 2; ++ks) acc = MFMA16(ldfrag((const char*)KDT, dt * 16, 72, ks * 32, lane), ldfrag((const char*)VT, et * 16, 72, ks * 32, lane), acc);
        float* Sl = (float*)(a.ws + WS_GSL) + (size_t)((b * 4 + h) * 128 + c) * 2048;
#pragma unroll
        for (int j = 0; j < 4; ++j) Sl[(dt * 16 + (lane >> 4) * 4 + j) * 64 + et * 16 + (lane & 15)] = acc[j];
        if (tid < 32) ((float*)(a.ws + WS_GBL))[(size_t)((b * 4 + h) * 128 + c) * 32 + tid] = LA[63 * 33 + tid];
        __syncthreads();
        return;
    } else {
#pragma unroll
        for (int x = 0; x < 2; ++x) { const int id = wave * 2 + x, it = id >> 2, jt = id & 3; f32x4 acc = {0.f, 0.f, 0.f, 0.f};
            if (jt <= it) acc = MFMA16(ldfrag((const char*)QE, it * 16, 40, 0, lane), ldfrag((const char*)KE, jt * 16, 40, 0, lane), acc);
#pragma unroll
            for (int j = 0; j < 4; ++j) { const int i_ = it * 16 + (lane >> 4) * 4 + j, j_ = jt * 16 + (lane & 15); ATT[i_ * 72 + j_] = (j_ <= i_) ? f2bf(acc[j]) : (bf16_t)0; } }
        __syncthreads();
#pragma unroll
        for (int x = 0; x < 2; ++x) { const int id = wave * 2 + x, it = id >> 2, et = id & 3; f32x4 acc = {0.f, 0.f, 0.f, 0.f};
#pragma unroll
            for (int ks = 0; ks < 2; ++ks) acc = MFMA16(ldfrag((const char*)ATT, it * 16, 72, ks * 32, lane), ldfrag((const char*)VT, et * 16, 72, ks * 32, lane), acc);
            acc = MFMA16(ldfrag((const char*)QE, it * 16, 40, 0, lane), ldfrag((const char*)SINT, et * 16, 40, 0, lane), acc);
#pragma unroll
            for (int j = 0; j < 4; ++j) OF[(it * 16 + (lane >> 4) * 4 + j) * 65 + et * 16 + (lane & 15)] = acc[j]; }
        __syncthreads();
        { float o[8]; float ss = 0.f;
#pragma unroll
          for (int e = 0; e < 8; ++e) { o[e] = OF[t * 65 + dg * 8 + e]; ss += o[e] * o[e]; }
          ss += __shfl_xor(ss, 1); ss += __shfl_xor(ss, 2); ss += __shfl_xor(ss, 4);
          const float ri = rsqrtf(ss * (1.f / 64.f) + EPS);
          float r8[8]; unpack8(ld_r, r8);
          const float* gn = a.in[17] + l * 256 + h * 64 + dg * 8; f32x4 w0, w1;
#pragma unroll
          for (int e = 0; e < 8; ++e) { float v = o[e] * ri * gn[e] * (r8[e] * sigmoidf_(r8[e]));

              if (e < 4) w0[e] = v; else w1[e - 4] = v; }
          *(u32x4*)((bf16_t*)(a.ws + WS_BR) + tok * DM + 512 + h * 64 + dg * 8) = pack8(w0, w1); }
        __syncthreads();
    }
}

__device__ __forceinline__ void s5_scan(const Args& a, int ch) {
    const int b = ch >> 10, gp = ch & 1023;
    const f32x2 l64 = ((const f32x2*)(a.ws + WS_S5P + 8192))[gp];
    const f32x2* E = (const f32x2*)(a.ws + WS_S5E) + (size_t)b * 128 * 1024 + gp; f32x2* C = (f32x2*)(a.ws + WS_S5C) + (size_t)b * 128 * 1024 + gp;
    float cr = 0.f, ci = 0.f;
    for (int c0 = 0; c0 < 128; c0 += 16) { f32x2 e[16];
#pragma unroll
        for (int i = 0; i < 16; ++i) e[i] = E[(size_t)(c0 + i) * 1024];
#pragma unroll
        for (int i = 0; i < 16; ++i) { C[(size_t)(c0 + i) * 1024] = (f32x2){cr, ci}; const float nr = l64[0] * cr - l64[1] * ci + e[i][0], ni = l64[0] * ci + l64[1] * cr + e[i][1]; cr = nr; ci = ni; } }
}
__device__ __forceinline__ void gla_scan(const Args& a, int idx) {
    const int bh = idx >> 11, de = idx & 2047, d = de >> 6;
    const float* Sl = (const float*)(a.ws + WS_GSL) + (size_t)bh * 128 * 2048 + de; float* Si = (float*)(a.ws + WS_GSI) + (size_t)bh * 128 * 2048 + de;
    const float* bl = (const float*)(a.ws + WS_GBL) + (size_t)bh * 128 * 32 + d;
    float s = 0.f;
    for (int c0 = 0; c0 < 128; c0 += 16) { float x[16], g[16];
#pragma unroll
        for (int i = 0; i < 16; ++i) { x[i] = Sl[(size_t)(c0 + i) * 2048]; g[i] = bl[(c0 + i) * 32]; }
#pragma unroll
        for (int i = 0; i < 16; ++i) { Si[(size_t)(c0 + i) * 2048] = s; s = __expf(g[i]) * s + x[i]; } }
}

constexpr int AT_KS = 0, AT_VT = 9216, AT_BUF = 18432;
__device__ __forceinline__ void attn_load(const bf16_t* proj, size_t tokbase, int kcol, int vcol, int tid, u32x4& kv, u32x4& vv) {
    const int key = tid & 63, c8 = tid >> 6;
    const bf16_t* p = proj + (tokbase + key) * PP;
    kv = *(const u32x4*)(p + kcol + c8 * 8); vv = *(const u32x4*)(p + vcol + c8 * 8);
}
__device__ __forceinline__ void attn_store(char* lds, int tid, const u32x4& kv, const u32x4& vv) {
    const int key = tid & 63, c8 = tid >> 6;
    const int rho = ((key >> 2) & 3) * 16 + (key >> 4) * 4 + (key & 3);
    *(u32x4*)(lds + AT_KS + (rho * 72 + c8 * 8) * 2) = kv;
    bf16_t* VT = (bf16_t*)(lds + AT_VT);
    const unsigned w[4] = {vv.x, vv.y, vv.z, vv.w};
#pragma unroll
    for (int e = 0; e < 4; ++e) { VT[(c8 * 8 + 2 * e) * 72 + key] = (bf16_t)(w[e] & 0xffffu); VT[(c8 * 8 + 2 * e + 1) * 72 + key] = (bf16_t)(w[e] >> 16); }
}

__device__ __forceinline__ void sb_item(const Args& a, char* lds, int item, int tid, int lane, int wave) {
    const int qb = item & 63, h = (item >> 6) & 3, b = item >> 8; const int q0 = qb * 128;
    const bf16_t* proj = (const bf16_t*)(a.ws + WS_ACT);
    const int fr = lane & 15, fq = lane >> 4; const int qpos = q0 + wave * 16 + fr;
    bf16x8 qf[2];
    { const bf16_t* qp = proj + ((size_t)b * SEQ + qpos) * PP + C_SBQ + h * 64 + fq * 8; qf[0] = *(const bf16x8*)qp; qf[1] = *(const bf16x8*)(qp + 32); }
    f32x4 o[4];
#pragma unroll
    for (int i = 0; i < 4; ++i) o[i] = (f32x4){0.f, 0.f, 0.f, 0.f};
    float R = 1.f;
    u32x4 kvr, vvr; attn_load(proj, (size_t)b * SEQ + ((q0 >> 6) + 1) * 64, C_SBK + h * 64, C_SBV + h * 64, tid, kvr, vvr);
    attn_store(lds, tid, kvr, vvr);
    __syncthreads();
    attn_load(proj, (size_t)b * SEQ + (q0 >> 6) * 64, C_SBK + h * 64, C_SBV + h * 64, tid, kvr, vvr);
    int buf = 0;
    for (int jt = (q0 >> 6) + 1; jt >= 0; --jt) {
        char* L = lds + buf * AT_BUF;
        f32x4 s[4];
#pragma unroll
        for (int i = 0; i < 4; ++i) { s[i] = (f32x4){0.f, 0.f, 0.f, 0.f};
#pragma unroll
            for (int ks = 0; ks < 2; ++ks) s[i] = MFMA16(ldfrag(L + AT_KS, i * 16, 72, ks * 32, lane), qf[ks], s[i]); }
        const int kbase = jt * 64 + fq * 16;
        float w[16]; float suf = 1.f;
#pragma unroll
        for (int kk = 15; kk >= 0; --kk) { const float z = fminf(s[kk >> 2][kk & 3] * 0.125f, 80.f); const float e = __expf(z); float keep = __builtin_amdgcn_rcpf(1.f + e); float beta = e * keep;
            if (kbase + kk >= qpos) { keep = 1.f; beta = 0.f; }
            w[kk] = beta * suf; suf *= keep; }
        const float t1 = __shfl(suf, (lane + 16) & 63), t2 = __shfl(suf, (lane + 32) & 63), t3 = __shfl(suf, (lane + 48) & 63);
        float mult = R; if (fq < 3) mult *= t1; if (fq < 2) mult *= t2; if (fq < 1) mult *= t3;
        float tot = suf * __shfl_xor(suf, 16); tot *= __shfl_xor(tot, 32);
        R *= tot;
        bf16x8 pb[2];
#pragma unroll
        for (int s2 = 0; s2 < 2; ++s2) { u32x4 pk; pk.x = cvt_pk_bf16(w[s2 * 8 + 0] * mult, w[s2 * 8 + 1] * mult); pk.y = cvt_pk_bf16(w[s2 * 8 + 2] * mult, w[s2 * 8 + 3] * mult);
            pk.z = cvt_pk_bf16(w[s2 * 8 + 4] * mult, w[s2 * 8 + 5] * mult); pk.w = cvt_pk_bf16(w[s2 * 8 + 6] * mult, w[s2 * 8 + 7] * mult); pb[s2] = __builtin_bit_cast(bf16x8, pk); }
#pragma unroll
        for (int dt = 0; dt < 4; ++dt)
#pragma unroll
            for (int s2 = 0; s2 < 2; ++s2) { const bf16x8 vf = *(const bf16x8*)(L + AT_VT + ((dt * 16 + fr) * 72 + fq * 16 + s2 * 8) * 2); o[dt] = MFMA16(vf, pb[s2], o[dt]); }
        const int alive = !(R < 1e-35f);
        if (jt > 0) attn_store(lds + (buf ^ 1) * AT_BUF, tid, kvr, vvr);
        if (!__syncthreads_or(alive)) break;
        if (jt > 1) attn_load(proj, (size_t)b * SEQ + (jt - 2) * 64, C_SBK + h * 64, C_SBV + h * 64, tid, kvr, vvr);
        buf ^= 1;
    }
    bf16_t* op = (bf16_t*)(a.ws + WS_BR) + ((size_t)b * SEQ + qpos) * DM + 0 + h * 64 + fq * 4;
#pragma unroll
    for (int dt = 0; dt < 4; ++dt) *(u32x2*)(op + dt * 16) = (u32x2){cvt_pk_bf16(o[dt][0], o[dt][1]), cvt_pk_bf16(o[dt][2], o[dt][3])};
    __syncthreads();
}

__device__ __forceinline__ void dsa_item(const Args& a, int l, char* lds, int item, int tid, int lane, int wave) {
    const int qb = item & 63, h = (item >> 6) & 3, b = item >> 8; const int q0 = qb * 128;
    const bf16_t* proj = (const bf16_t*)(a.ws + WS_ACT);
    const int fr = lane & 15, fq = lane >> 4; const int qpos = q0 + wave * 16 + fr;
    float bound;
    { float gq = fabsf(a.in[18][l * 64 + lane]), gk = fabsf(a.in[19][l * 64 + lane]);
#pragma unroll
      for (int o = 1; o < 64; o <<= 1) { gq = fmaxf(gq, __shfl_xor(gq, o)); gk = fmaxf(gk, __shfl_xor(gk, o)); }
      bound = 8.f * gq * gk * 1.02f; }
    bf16x8 qf[2];
    { const bf16_t* qp = proj + ((size_t)b * SEQ + qpos) * PP + C_DQ + h * 64 + fq * 8; qf[0] = *(const bf16x8*)qp; qf[1] = *(const bf16x8*)(qp + 32); }
    f32x4 o[4];
#pragma unroll
    for (int i = 0; i < 4; ++i) o[i] = (f32x4){0.f, 0.f, 0.f, 0.f};
    float lsum = 0.f;
    int jlo = (q0 - 2048) >> 6; if (jlo < 0) jlo = 0;
    u32x4 kvr, vvr; attn_load(proj, (size_t)b * SEQ + ((q0 >> 6) + 1) * 64, C_DK + h * 64, C_DV + h * 64, tid, kvr, vvr);
    attn_store(lds, tid, kvr, vvr);
    __syncthreads();
    attn_load(proj, (size_t)b * SEQ + (q0 >> 6) * 64, C_DK + h * 64, C_DV + h * 64, tid, kvr, vvr);
    int buf = 0;
    for (int jt = (q0 >> 6) + 1; jt >= jlo; --jt) {
        char* L = lds + buf * AT_BUF;
        f32x4 s[4];
#pragma unroll
        for (int i = 0; i < 4; ++i) { s[i] = (f32x4){0.f, 0.f, 0.f, 0.f};
#pragma unroll
            for (int ks = 0; ks < 2; ++ks) s[i] = MFMA16(ldfrag(L + AT_KS, i * 16, 72, ks * 32, lane), qf[ks], s[i]); }
        const int d0 = qpos - (jt * 64 + fq * 16);
        const int dmin = (q0 + wave * 16) - (jt * 64 + 63);
        float w[16];
        if (dmin > 512) {
            const int ks_ = d0 & 15, ci = ks_ & 3, ii = ks_ >> 2; const int d = d0 - ks_;
            const f32x4 sv = (ii == 0) ? s[0] : (ii == 1) ? s[1] : (ii == 2) ? s[2] : s[3];
            const float val = (ci == 0) ? sv[0] : (ci == 1) ? sv[1] : (ci == 2) ? sv[2] : sv[3];
            const float p = (d >= 0 && d <= 2048) ? __expf(val - bound) : 0.f;
            lsum += p;
#pragma unroll
            for (int kk = 0; kk < 16; ++kk) w[kk] = (kk == ks_) ? p : 0.f;
        } else if (dmin > 128) {
            const int ci = d0 & 3;
#pragma unroll
            for (int i = 0; i < 4; ++i) { const float val = (ci == 0) ? s[i][0] : (ci == 1) ? s[i][1] : (ci == 2) ? s[i][2] : s[i][3];
                const int d = d0 - (4 * i + ci);
                const int m = ((d <= 512) ? 1 : 0) + ((d <= 2048 && (d & 15) == 0) ? 1 : 0) + ((d <= 128) ? 1 : 0);
                const float p = (d >= 0 && m > 0) ? (float)m * __expf(val - bound) : 0.f;
                lsum += p;
#pragma unroll
                for (int c = 0; c < 4; ++c) w[4 * i + c] = (c == ci) ? p : 0.f; }
        } else {
#pragma unroll
            for (int kk = 0; kk < 16; ++kk) { const int d = d0 - kk;
                const int m = (d <= 128 ? 1 : 0) + ((d <= 512 && (d & 3) == 0) ? 1 : 0) + ((d <= 2048 && (d & 15) == 0) ? 1 : 0);
                const float p = (d >= 0 && m > 0) ? (float)m * __expf(s[kk >> 2][kk & 3] - bound) : 0.f;
                w[kk] = p; lsum += p; }
        }
        bf16x8 pb[2];
#pragma unroll
        for (int s2 = 0; s2 < 2; ++s2) { u32x4 pk; pk.x = cvt_pk_bf16(w[s2 * 8 + 0], w[s2 * 8 + 1]); pk.y = cvt_pk_bf16(w[s2 * 8 + 2], w[s2 * 8 + 3]);
            pk.z = cvt_pk_bf16(w[s2 * 8 + 4], w[s2 * 8 + 5]); pk.w = cvt_pk_bf16(w[s2 * 8 + 6], w[s2 * 8 + 7]); pb[s2] = __builtin_bit_cast(bf16x8, pk); }
#pragma unroll
        for (int dt = 0; dt < 4; ++dt)
#pragma unroll
            for (int s2 = 0; s2 < 2; ++s2) { const bf16x8 vf = *(const bf16x8*)(L + AT_VT + ((dt * 16 + fr) * 72 + fq * 16 + s2 * 8) * 2); o[dt] = MFMA16(vf, pb[s2], o[dt]); }
        if (jt > jlo) attn_store(lds + (buf ^ 1) * AT_BUF, tid, kvr, vvr);
        __syncthreads();
        if (jt > jlo + 1) attn_load(proj, (size_t)b * SEQ + (jt - 2) * 64, C_DK + h * 64, C_DV + h * 64, tid, kvr, vvr);
        buf ^= 1;
    }
    lsum += __shfl_xor(lsum, 16); lsum += __shfl_xor(lsum, 32);
    const float inv = 1.f / lsum;
    bf16_t* op = (bf16_t*)(a.ws + WS_BR) + ((size_t)b * SEQ + qpos) * DM + 768 + h * 64 + fq * 4;
#pragma unroll
    for (int dt = 0; dt < 4; ++dt) *(u32x2*)(op + dt * 16) = (u32x2){cvt_pk_bf16(o[dt][0] * inv, o[dt][1] * inv), cvt_pk_bf16(o[dt][2] * inv, o[dt][3] * inv)};
}

__device__ __forceinline__ float gelu_tanh(float x) { const float u = 0.7978845608028654f * (x + 0.044715f * x * x * x); const float e = __expf(2.f * u); const float th = 1.f - 2.f * __builtin_amdgcn_rcpf(e + 1.f); return 0.5f * x * (1.f + th); }
__device__ __forceinline__ void s5_main_item(const Args& a, int l, char* lds, int item, int lane, int wave) {
    const int c = item & 127, b = item >> 7;
    const bf16_t* proj = (const bf16_t*)(a.ws + WS_ACT);
    const f32x2* lamb = (const f32x2*)(a.ws + WS_S5P); const f32x2* bbar = (const f32x2*)(a.ws + WS_S5P + 16384); const float* ct = (const float*)(a.ws + WS_S5P + 16384 + 131072);
    const f32x2* C = (const f32x2*)(a.ws + WS_S5C); bf16_t* Y = (bf16_t*)(a.ws + WS_YS5);
    float* U = (float*)(lds + wave * 12544); f32x2* ST = (f32x2*)(lds + wave * 12544 + 4096);
    for (int gi = 0; gi < 2; ++gi) { const int g = wave * 2 + gi;
        s5_load_u(proj, b, c, g, U, lane);
        const f32x2 lam = lamb[g * 64 + lane];
        const f32x2* abp = bbar + (size_t)(g * 16 + 4 * (lane >> 4)) * 64 + (lane & 15);
        const f32x2 c0 = C[(size_t)((b * 128 + c) * 16 + g) * 64 + lane];
        float sr = c0[0], si = c0[1];
        const int tt2 = lane & 15, hq = lane >> 4;
        const f32x4 dsk = *(const f32x4*)(a.in[13] + l * 256 + g * 16 + hq * 4);
        float cmf[32];
#pragma unroll
        for (int s2 = 0; s2 < 32; ++s2) { const float v = ct[(size_t)(g * 64 + hq * 16 + (s2 >> 1)) * 32 + (s2 & 1) * 16 + tt2]; cmf[s2] = (s2 & 1) ? -v : v; }
        for (int tb = 0; tb < 4; ++tb) {
            { const f32x4 uvp = *(const f32x4*)(U + (tb * 16 + tt2) * 16 + 4 * hq);
#pragma unroll
              for (int pt = 0; pt < 4; ++pt) { f32x4 dr = {0.f, 0.f, 0.f, 0.f}, di = {0.f, 0.f, 0.f, 0.f};
#pragma unroll
                  for (int s2 = 0; s2 < 4; ++s2) { const f32x2 av = abp[s2 * 64 + pt * 16]; dr = __builtin_amdgcn_mfma_f32_16x16x4f32(av[0], uvp[s2], dr, 0, 0, 0); di = __builtin_amdgcn_mfma_f32_16x16x4f32(av[1], uvp[s2], di, 0, 0, 0); }
#pragma unroll
                  for (int j = 0; j < 4; ++j) ST[tt2 * 66 + pt * 16 + hq * 4 + j] = (f32x2){dr[j], di[j]}; } }
            LDS_WAIT();
#pragma unroll 4
            for (int tt = 0; tt < 16; ++tt) { const f32x2 v = ST[tt * 66 + lane];
                const float nr = lam[0] * sr - lam[1] * si + v[0], ni = lam[0] * si + lam[1] * sr + v[1]; sr = nr; si = ni;
                ST[tt * 66 + lane] = (f32x2){sr, si}; }
            LDS_WAIT();
            f32x4 y = {0.f, 0.f, 0.f, 0.f};
            { const f32x4* sp = (const f32x4*)((const float*)ST + tt2 * 132 + hq * 32);
#pragma unroll
              for (int q = 0; q < 8; ++q) { const f32x4 sv = sp[q];
                  const float c0 = cmf[4 * q], c1 = cmf[4 * q + 1], c2 = cmf[4 * q + 2], c3 = cmf[4 * q + 3];
                  y = __builtin_amdgcn_mfma_f32_16x16x4f32(c0, sv[0], y, 0, 0, 0); y = __builtin_amdgcn_mfma_f32_16x16x4f32(c1, sv[1], y, 0, 0, 0);
                  y = __builtin_amdgcn_mfma_f32_16x16x4f32(c2, sv[2], y, 0, 0, 0); y = __builtin_amdgcn_mfma_f32_16x16x4f32(c3, sv[3], y, 0, 0, 0); } }
            const int t = tb * 16 + tt2; const f32x4 uv = *(const f32x4*)(U + t * 16 + hq * 4);
            y = y + dsk * uv;
            *(u32x2*)(Y + ((size_t)b * SEQ + c * 64 + t) * 256 + g * 16 + hq * 4) = (u32x2){cvt_pk_bf16(gelu_tanh(y[0]), gelu_tanh(y[1])), cvt_pk_bf16(gelu_tanh(y[2]), gelu_tanh(y[3]))};
            LDS_WAIT();
        }
    }
}

#define XB_TMO      128
#define XB_XCNT(j)  (256  + 64 * (j))
#define XB_XSUB(j)  (1280 + 64 * (j))
#define XB_XGEN(j)  (2304 + 64 * (j))
#define XB_TOP      3328
#define XB_TOPGEN   3392
#define XCD_BAR_WORDS 3456
#define XB_SPIN_CAP (1u << 18)
__device__ __forceinline__ unsigned xb_ld(unsigned* p)              { return __hip_atomic_load(p, __ATOMIC_RELAXED, __HIP_MEMORY_SCOPE_AGENT); }
__device__ __forceinline__ unsigned xb_add(unsigned* p, unsigned v) { return __hip_atomic_fetch_add(p, v, __ATOMIC_RELAXED, __HIP_MEMORY_SCOPE_AGENT); }
__device__ __forceinline__ unsigned xb_xcc_id() { return (unsigned)__builtin_amdgcn_s_getreg((3 << 11) | 20) & 0xFu; }
#define XB_SPIN(cond, bar) do { unsigned _sp = 0; while (cond) { __builtin_amdgcn_s_sleep(1); \
    if ((++_sp & 255u) == 0u) { if (xb_ld(&(bar)[XB_TMO])) break; if (_sp > XB_SPIN_CAP) { atomicAdd(&(bar)[XB_TMO], 1u); break; } } } } while (0)
__device__ __forceinline__ void xcd_barrier_complete(unsigned* bar, unsigned x, unsigned& nloc, unsigned& nx) {
    const unsigned G = gridDim.x * gridDim.y * gridDim.z;
    unsigned sum, cnt, mine, sp = 0u;
    for (;;) {
        sum = 0u; cnt = 0u; mine = 0u;
#pragma unroll
        for (unsigned j = 0; j < 16; ++j) { const unsigned c = xb_ld(&bar[XB_XCNT(j)]); sum += c; cnt += (c > 0u) ? 1u : 0u; mine = (j == x) ? c : mine; }
        if (sum == G) break;
        __builtin_amdgcn_s_sleep(1);
        if ((++sp & 255u) == 0u) { if (xb_ld(&bar[XB_TMO])) break; if (sp > XB_SPIN_CAP) { atomicAdd(&bar[XB_TMO], 1u); break; } }
    }
    nloc = mine > 0u ? mine : 1u; nx = cnt > 0u ? cnt : 1u;
}
__device__ __forceinline__ void xcd_barrier(unsigned* bar, volatile LAS unsigned* st) {
    asm volatile("s_waitcnt vmcnt(0)" ::: "memory");
    __syncthreads();
    if (threadIdx.x == 0) {
        const unsigned x = xb_xcc_id();
        __builtin_amdgcn_s_waitcnt(0);
        unsigned nloc = st[0], nx = st[1];
        if (nloc == 0u) { xcd_barrier_complete(bar, x, nloc, nx); st[0] = nloc; st[1] = nx; }
        const unsigned old = xb_add(&bar[XB_XSUB(x)], 1u);
        const unsigned gen = old / nloc;
        if (old + 1u == (gen + 1u) * nloc) {
            __builtin_amdgcn_fence(__ATOMIC_RELEASE, "agent");
            asm volatile("s_waitcnt vmcnt(0)" ::: "memory");
            const unsigned og = xb_add(&bar[XB_TOP], 1u);
            const unsigned tg = og / nx;
            if (og + 1u == (tg + 1u) * nx) xb_add(&bar[XB_TOPGEN], 1u);
            else XB_SPIN(xb_ld(&bar[XB_TOPGEN]) == tg, bar);
            __builtin_amdgcn_fence(__ATOMIC_ACQUIRE, "agent");
            xb_add(&bar[XB_XGEN(x)], 1u);
            asm volatile("s_waitcnt vmcnt(0)" ::: "memory");
        } else {
            XB_SPIN(xb_ld(&bar[XB_XGEN(x)]) == gen, bar);
            __builtin_amdgcn_fence(__ATOMIC_ACQUIRE, "agent");
            asm volatile("s_waitcnt vmcnt(0)" ::: "memory");
        }
    }
    __syncthreads();
}
constexpr int LDS_BARST = LDS_BYTES - 64;

enum { PH_CONV = 0, PH_FFN1A, PH_FFN1B, PH_PROJ, PH_MIXPRE, PH_MIXA, PH_MIXB, PH_GLU, PH_GATE, PH_PB0, PH_WOUT, PH_FFN2A, PH_FFN2B, PH_PER_LAYER };
constexpr int N_PHASES = 2 * PH_PER_LAYER;

#ifndef ENMASK
#define ENMASK 0xFFFFF
#endif
typedef const __attribute__((address_space(4))) Args* KArgP;
__device__ __forceinline__ Args load_args() {
#if defined(__HIP_DEVICE_COMPILE__)
    KArgP p = (KArgP)__builtin_amdgcn_kernarg_segment_ptr(); asm volatile("" : "+s"(p)); Args r;
#pragma unroll
    for (int i = 0; i < 25; ++i) r.in[i] = p->in[i];
    r.out = p->out; r.ws = p->ws; r.ph_lo = p->ph_lo; r.ph_hi = p->ph_hi; return r;
#else
    return Args{};
#endif
}
#ifndef DUPMASK
#define DUPMASK 0
#endif
#define REP(k) for (int rep_ = 0; rep_ < 1 + ((DUPMASK >> (k)) & 1); ++rep_)
#define RUN(k) (((ENMASK >> (k)) & 1) && lo <= l * PH_PER_LAYER + (k) && l * PH_PER_LAYER + (k) < hi)
#define SEAM(k) do { if (l * PH_PER_LAYER + (k) + 1 < hi) xcd_barrier((unsigned*)(load_args().ws + WS_BARW), (volatile LAS unsigned*)(ldsl + LDS_BARST)); } while (0)
template <int l>
__device__ __forceinline__ void layer_body(int lo, int hi, cg::grid_group& grid, LAS unsigned char* ldsl, char* lds) {
    const int tid = threadIdx.x, lane = tid & 63, wave = __builtin_amdgcn_readfirstlane(tid >> 6);
    const int G = gridDim.x, bx = blockIdx.x; const int gw = bx * NWAVES + wave, NGW = G * NWAVES;
#define PH_LOCALS const Args a = load_args(); unsigned char* ws = a.ws; float* rowsq = (float*)(ws + WS_ROWSQ); \
    bf16_t* HB = (bf16_t*)(ws + WS_HB); bf16_t* ACT = (bf16_t*)(ws + WS_ACT); bf16_t* BR = (bf16_t*)(ws + WS_BR); bf16_t* MX = (bf16_t*)(ws + WS_MIX); \
    (void)rowsq; (void)HB; (void)ACT; (void)BR; (void)MX;
        if (RUN(PH_CONV)) REP(PH_CONV) { PH_LOCALS phase_convert(a, l, lds, gw, NGW, lane, wave); SEAM(PH_CONV); }
        if (RUN(PH_FFN1A)) REP(PH_FFN1A) { PH_LOCALS
            pg8::StdSched S; S.init(HB, ws + WS_W1T, T, 2 * FF, DM, DM, DM, G, bx);
            pg8::EpiGLU E{ACT, FF, 0, rowsq + (size_t)(l * 3 + 0) * T, 0};
            pg8::gemm_phase(ldsl, DM, DM, S, E); SEAM(PH_FFN1A); }
        if (RUN(PH_FFN1B)) REP(PH_FFN1B) { PH_LOCALS
            pg8::StdSched S; S.init(ACT, ws + WS_W2T, T, DM, FF, FF, FF, G, bx);
            pg8::EpiResid E{l == 0 ? a.in[0] : a.out, a.out, HB, rowsq + (size_t)(l * 3 + 1) * T, 0.5f};
            pg8::gemm_phase(ldsl, FF, FF, S, E); SEAM(PH_FFN1B); }
        if (RUN(PH_PROJ)) REP(PH_PROJ) { PH_LOCALS
            pg8::StdSched S; S.init(HB, ws + WS_WPT, T, PP, DM, DM, DM, G, bx);
            pg8::EpiProj E{ACT, PP, C_GATE, rowsq + (size_t)(l * 3 + 1) * T, 0};
            pg8::gemm_phase(ldsl, DM, DM, S, E); SEAM(PH_PROJ); }
        if (RUN(PH_MIXPRE)) REP(PH_MIXPRE) { PH_LOCALS
#ifndef NO_S5
            dsa_rope_phase(a, l, gw, NGW, lane);
            s5_pre_phase(a, lds, gw, NGW, lane, wave);
#endif
            __syncthreads();
            for (int it = bx; it < 1024; it += G) gla_item<false>(a, l, lds, it, tid, lane, wave);
            SEAM(PH_MIXPRE); }
        if (RUN(PH_MIXA)) { PH_LOCALS
            unsigned* qctr = (unsigned*)(ws + WS_BARW) + XCD_BAR_WORDS + l; volatile LAS unsigned* qslot = (volatile LAS unsigned*)(ldsl + LDS_BARST + 16);
            if (bx < 4) s5_scan(a, bx * NTHR + tid);
            else if (bx < 36) gla_scan(a, (bx - 4) * NTHR + tid);
            for (;;) {
                if (tid == 0) *qslot = xb_add(qctr, 1u);
                __syncthreads();
                const int it = __builtin_amdgcn_readfirstlane((int)*qslot);
                __syncthreads();
                if (it >= 1024) break;
                if (it < 512) dsa_item(a, l, lds, it ^ 63, tid, lane, wave);
                else sb_item(a, lds, it - 512, tid, lane, wave);
            }
            SEAM(PH_MIXA); }
        if (RUN(PH_MIXB)) REP(PH_MIXB) { PH_LOCALS
            for (int it = bx; it < 1280; it += G) { if (it < 256) {
#ifndef NO_S5
                s5_main_item(a, l, lds, it, lane, wave); __syncthreads();
#endif
            } else gla_item<true>(a, l, lds, it - 256, tid, lane, wave); }
            SEAM(PH_MIXB); }
        if (RUN(PH_GLU)) REP(PH_GLU) { PH_LOCALS
            pg8::StdSched S; S.init(ws + WS_YS5, ws + WS_WGLUT, T, 512, 256, 256, 256, G, bx);
            pg8::EpiGLU E{BR, DM, 256, nullptr, 1};
            pg8::gemm_phase(ldsl, 256, 256, S, E); SEAM(PH_GLU); }
        if (RUN(PH_GATE)) REP(PH_GATE) { PH_LOCALS
            pg8::StdSched S; S.init(HB, ws + WS_WGT, T, 4096, DM, DM, DM, G, bx);
            pg8::EpiProj E{(bf16_t*)(ws + WS_G), 4096, 4096, rowsq + (size_t)(l * 3 + 1) * T, 2};
            pg8::gemm_phase(ldsl, DM, DM, S, E); SEAM(PH_GATE); }
        if (RUN(PH_PB0)) { PH_LOCALS
            pg8::PbSched S; S.init(BR, ws + WS_WBT, G, bx);
            pg8::EpiPb E{MX, (const bf16_t*)(ws + WS_G), -1};
            pg8::gemm_phase(ldsl, DM, DM, S, E); SEAM(PH_PB0); }
        if (RUN(PH_WOUT)) REP(PH_WOUT) { PH_LOCALS
            pg8::StdSched S; S.init(MX, ws + WS_WOT, T, DM, DM, DM, DM, G, bx);
            pg8::EpiResid E{a.out, a.out, (bf16_t*)(ws + WS_HB2), rowsq + (size_t)(l * 3 + 2) * T, 1.0f};
            pg8::gemm_phase(ldsl, DM, DM, S, E); SEAM(PH_WOUT); }
        if (RUN(PH_FFN2A)) REP(PH_FFN2A) { PH_LOCALS
            pg8::StdSched S; S.init(ws + WS_HB2, ws + WS_W3T, T, 2 * FF, DM, DM, DM, G, bx);
            pg8::EpiGLU E{ACT, FF, 0, rowsq + (size_t)(l * 3 + 2) * T, 0};
            pg8::gemm_phase(ldsl, DM, DM, S, E); SEAM(PH_FFN2A); }
        if (RUN(PH_FFN2B)) REP(PH_FFN2B) { PH_LOCALS
            pg8::StdSched S; S.init(ACT, ws + WS_W4T, T, DM, FF, FF, FF, G, bx);
            pg8::EpiResid E{a.out, a.out, l == 0 ? HB : nullptr, l == 0 ? rowsq + (size_t)3 * T : nullptr, 0.5f};
            pg8::gemm_phase(ldsl, FF, FF, S, E); SEAM(PH_FFN2B); }
}

__global__ void __launch_bounds__(NTHR, 2) mega(Args a) {
    extern __shared__ __attribute__((aligned(16))) unsigned char lds_raw[];
    LAS unsigned char* ldsl = (LAS unsigned char*)lds_raw; char* lds = (char*)lds_raw;
    cg::grid_group grid = cg::this_grid();
    const int lo = a.ph_lo, hi = a.ph_hi;
    if (lo < 0) grid.sync();
    if (threadIdx.x == 0) { volatile LAS unsigned* st = (volatile LAS unsigned*)(ldsl + LDS_BARST); st[0] = 0u; st[1] = 0u;
        (void)xb_add(&((unsigned*)(a.ws + WS_BARW))[XB_XCNT(xb_xcc_id())], 1u); }
    __syncthreads();
    layer_body<0>(lo, hi, grid, ldsl, lds);
    layer_body<1>(lo, hi, grid, ldsl, lds);
}

extern "C" void kernel_launch(void* const* d_in, const int* in_sizes, int n_in, void* d_out, int out_size, void* d_ws, size_t ws_size, hipStream_t stream) {
    static int grid = 0;
    if (grid == 0) {
        if (n_in != 25 || in_sizes[0] != T * DM || out_size != T * DM || ws_size < WS_END) { fprintf(stderr, "kernel_launch: unexpected shapes (n_in %d, in0 %d, out %d, ws %zu < %zu)\n", n_in, n_in > 0 ? in_sizes[0] : -1, out_size, ws_size, (size_t)WS_END); grid = -1; return; }
        int dev = 0, cus = 0, per_cu = 0;
        (void)hipGetDevice(&dev); (void)hipDeviceGetAttribute(&cus, hipDeviceAttributeMultiprocessorCount, dev);
        if (hipFuncSetAttribute((const void*)mega, hipFuncAttributeMaxDynamicSharedMemorySize, LDS_BYTES) != hipSuccess) { fprintf(stderr, "kernel_launch: hipFuncSetAttribute failed\n"); grid = -1; return; }
        if (hipOccupancyMaxActiveBlocksPerMultiprocessor(&per_cu, (const void*)mega, NTHR, LDS_BYTES) != hipSuccess || per_cu < 1) { fprintf(stderr, "kernel_launch: occupancy query says %d\n", per_cu); per_cu = 1; }
        (void)hipGetLastError();
        grid = cus * per_cu;
    }
    if (grid < 0) return;
    Args a{};
    for (int i = 0; i < 25; ++i) a.in[i] = (const float*)d_in[i];
    a.out = (float*)d_out; a.ws = (unsigned char*)d_ws; a.ph_lo = 0; a.ph_hi = N_PHASES;
#if defined(MK_PER_PHASE)
    for (int ph = 0; ph < N_PHASES; ++ph) { a.ph_lo = ph; a.ph_hi = ph + 1; hipLaunchKernelGGL(mega, dim3(grid), dim3(NTHR), LDS_BYTES, stream, a); }
    hipError_t e = hipPeekAtLastError();
#else
    (void)hipMemsetAsync((char*)d_ws + WS_BARW, 0, (XCD_BAR_WORDS + 64) * 4, stream);
    void* args[] = {&a};
    hipError_t e = hipLaunchCooperativeKernel((const void*)mega, dim3(grid), dim3(NTHR), args, LDS_BYTES, stream);
#endif
    if (e != hipSuccess) fprintf(stderr, "kernel_launch: cooperative launch failed: %s (grid %d)\n", hipGetErrorString(e), grid);
}
```

```cpp
#include <hip/hip_runtime.h>
#include <hip/hip_cooperative_groups.h>
#include <cstdio>
#include <cstdint>
namespace cg = cooperative_groups;

#define LAS __attribute__((address_space(3)))
typedef unsigned short bf16_t;
typedef short bf16x8 __attribute__((ext_vector_type(8)));
typedef float f32x4 __attribute__((ext_vector_type(4)));
typedef float f32x2 __attribute__((ext_vector_type(2)));
typedef unsigned u32x4 __attribute__((ext_vector_type(4)));
typedef unsigned u32x2 __attribute__((ext_vector_type(2)));

constexpr int T = 16384, DM = 1024, FF = 2816, SEQ = 8192;
constexpr int PP = 2816;
constexpr int C_SBQ = 0, C_SBK = 256, C_SBV = 512, C_S5U = 768, C_GQ = 1024, C_GK = 1152, C_GV = 1280, C_GR = 1536, C_GG = 1792,
              C_DQ = 1808, C_DK = 2064, C_DV = 2320, C_GATE = 2576, IN_W = 6672;
constexpr float EPS = 1e-6f;
constexpr int NTHR = 512, NWAVES = 8;
constexpr int LDS_BYTES = 135168;

constexpr size_t MiB = 1u << 20;
constexpr size_t WS_W1T = 0, WS_W2T = 11 * MiB, WS_WPT = 16 * MiB + 512 * 1024, WS_WGT = 22 * MiB, WS_WBT = 30 * MiB, WS_WOT = 32 * MiB,
                 WS_W3T = 34 * MiB, WS_W4T = 45 * MiB, WS_WGLUT = 50 * MiB + 512 * 1024;
constexpr size_t WS_HB = 51 * MiB;
constexpr size_t WS_MIX = WS_HB;
constexpr size_t WS_BR = 83 * MiB;
constexpr size_t WS_HB2 = WS_BR;
constexpr size_t WS_ACT = 115 * MiB;
constexpr size_t WS_G = WS_ACT;
constexpr size_t WS_TAIL = WS_ACT + 88 * MiB;
constexpr size_t WS_YS5 = WS_TAIL;
constexpr size_t WS_GSL = WS_YS5 + 8 * MiB;
constexpr size_t WS_GSI = WS_GSL + 8 * MiB;
constexpr size_t WS_S5E = WS_GSI + 8 * MiB;
constexpr size_t WS_S5C = WS_S5E + 2 * MiB;
constexpr size_t WS_MISC = 243 * MiB;
constexpr size_t WS_ROWSQ = WS_MISC;
constexpr size_t WS_ROPE = WS_MISC + 512 * 1024;
constexpr size_t WS_S5P = WS_ROPE + 2 * MiB;
constexpr size_t WS_GBL = WS_S5P + 512 * 1024;
constexpr size_t WS_BARW = WS_GBL + 512 * 1024;
constexpr size_t WS_END = WS_GBL + 1 * MiB;

typedef __bf16 bf16x2_t __attribute__((ext_vector_type(2)));
__device__ __forceinline__ unsigned cvt_pk_bf16(float lo, float hi) { f32x2 v = {lo, hi}; bf16x2_t b = __builtin_convertvector(v, bf16x2_t); return __builtin_bit_cast(unsigned, b); }
__device__ __forceinline__ float bflo(unsigned u) { return __uint_as_float(u << 16); }
__device__ __forceinline__ float bfhi(unsigned u) { return __uint_as_float(u & 0xffff0000u); }
__device__ __forceinline__ float bf1(bf16_t h) { return __uint_as_float(((unsigned)h) << 16); }
__device__ __forceinline__ bf16_t f2bf(float f) { return (bf16_t)(cvt_pk_bf16(f, 0.f) & 0xffffu); }
__device__ __forceinline__ u32x4 pack8(f32x4 a, f32x4 b) { u32x4 w; w.x = cvt_pk_bf16(a[0], a[1]); w.y = cvt_pk_bf16(a[2], a[3]); w.z = cvt_pk_bf16(b[0], b[1]); w.w = cvt_pk_bf16(b[2], b[3]); return w; }
__device__ __forceinline__ void unpack8(u32x4 w, float* f) { f[0] = bflo(w.x); f[1] = bfhi(w.x); f[2] = bflo(w.y); f[3] = bfhi(w.y); f[4] = bflo(w.z); f[5] = bfhi(w.z); f[6] = bflo(w.w); f[7] = bfhi(w.w); }
__device__ __forceinline__ float sigmoidf_(float x) { return __builtin_amdgcn_rcpf(1.f + __expf(-x)); }
#define LDS_WAIT() asm volatile("s_waitcnt lgkmcnt(0)" ::: "memory")

namespace pg8 {
constexpr int BM = 256, BK = 64, HALF = 128, HTB = HALF * BK * 2, NXCD = 8, WGM = 8;
__host__ __device__ __forceinline__ int lds_byte(int r, int c) { const int st = (r >> 4) * 2 + (c >> 5), rr = r & 15, cc = c & 31, ob = rr * 64 + cc * 2; return st * 1024 + (ob ^ (((ob >> 9) & 1) << 5)); }
__host__ __device__ __forceinline__ void stage_rc(int b, int& R, int& C) { const int st = b / 1024, sb = b % 1024, swz = sb ^ (((sb >> 9) & 1) << 5); R = (st >> 1) * 16 + swz / 64; C = (st & 1) * 32 + (swz % 64) / 2; }
__host__ __device__ __forceinline__ int perm32(int rho) { const int n = rho >> 4, i = rho & 15; return 8 * (i >> 2) + 4 * n + (i & 3); }
struct Unit { int pm, pn, kind; };

__device__ __forceinline__ void tile_map(int L, int nM, int nN, int& pm, int& pn) {
    const int nwg = nM * nN; int wgid = L;
    { const int q = nwg / NXCD, r = nwg % NXCD, xcd = wgid % NXCD, off = wgid / NXCD; wgid = (xcd < r ? xcd * (q + 1) : r * (q + 1) + (xcd - r) * q) + off; }
    const int nig = WGM * nN, gid = wgid / nig, fm = gid * WGM, gsz = (nM - fm) < WGM ? (nM - fm) : WGM;
    pm = fm + ((wgid % nig) % gsz); pn = (wgid % nig) / gsz;
}
struct StdSched {
    const char* A; const char* Bt; size_t tsA, tsB; int ntk; int nM, nN, nwg, G, c;
    __device__ __forceinline__ void init(const void* A_, const void* Bt_, int M, int N, int K, int lda, int ldb, int G_, int c_) {
        A = (const char*)A_; Bt = (const char*)Bt_; tsA = (size_t)BM * lda * 2; tsB = (size_t)BM * ldb * 2; ntk = K / BK; nM = M / BM; nN = N / BM; nwg = nM * nN; G = G_; c = c_; }
    __device__ __forceinline__ bool next(int i, Unit& u) const { const long L = (long)i * G + c; if (L >= nwg) return false; tile_map((int)L, nM, nN, u.pm, u.pn); u.kind = 0; return true; }
    __device__ __forceinline__ const char* pa(const Unit& u) const { return A + (size_t)u.pm * tsA; }
    __device__ __forceinline__ const char* pb(const Unit& u) const { return Bt + (size_t)u.pn * tsB; }
    __device__ __forceinline__ int nt(const Unit&) const { return ntk; }
};
struct PbSched {
    const char* A; const char* Bt; int G, c;
    __device__ __forceinline__ void init(const void* A_, const void* Bt_, int G_, int c_) { A = (const char*)A_; Bt = (const char*)Bt_; G = G_; c = c_; }
    __device__ __forceinline__ bool next(int i, Unit& u) const { const long L = (long)(i >> 2) * G + c; if (L >= 256) return false; tile_map((int)L, 64, 4, u.pm, u.pn); u.kind = i & 3; return true; }
    __device__ __forceinline__ const char* pa(const Unit& u) const { return A + (size_t)u.pm * (256 * 1024 * 2) + u.kind * 512; }
    __device__ __forceinline__ const char* pb(const Unit& u) const { return Bt + (size_t)u.pn * (256 * 1024 * 2) + u.kind * 512; }
    __device__ __forceinline__ int nt(const Unit&) const { return 4; }
};

template <class Epi, class Sched>
__device__ __forceinline__ void gemm_phase(LAS unsigned char* lds, int lda, int ldb, const Sched& S, const Epi& E) {
    const int tid = threadIdx.x, wid = __builtin_amdgcn_readfirstlane(tid >> 6), lane = tid & 63, wr = wid >> 2, wc = wid & 3, fr = lane & 15, fq = lane >> 4;
    unsigned voffA[2], voffB[2];
#pragma unroll
    for (int i = 0; i < 2; ++i) { int R, C; stage_rc(tid * 16 + i * 8192, R, C); const int Rb = (R & ~31) + perm32(R & 31);
        voffA[i] = (unsigned)(R * lda + C) * 2u; voffB[i] = (unsigned)(Rb * ldb + C) * 2u; }
    const size_t kstep = (size_t)(BK * 2);
    const size_t hsA = (size_t)HALF * lda * 2, hsB = (size_t)HALF * ldb * 2;
    const unsigned ldsw = (unsigned)wid * 1024u;
    const int aoff = lds_byte(wr * 64 + fr, fq * 8), boff = lds_byte(wc * 32 + fr, fq * 8);
#define PG8_SA(b, h) (((b) * 2 + (h)) * HTB)
#define PG8_SB(b, h) ((4 + (b) * 2 + (h)) * HTB)
#define PG8_STAGE(bufoff, gbase, voff) do { _Pragma("unroll") for (int _i = 0; _i < 2; ++_i) \
        __builtin_amdgcn_global_load_lds((const unsigned*)((const char*)(gbase) + (voff)[_i]), (LAS unsigned*)(lds + (bufoff) + ldsw + _i * 8192), 16, 0, 0); } while (0)
#define PG8_LDA(dst, b, h) do { _Pragma("unroll") for (int m = 0; m < 4; ++m) _Pragma("unroll") for (int k = 0; k < 2; ++k) dst[m][k] = *(const LAS bf16x8*)(lds + PG8_SA(b, h) + aoff + m * 2048 + k * 1024); } while (0)
#define PG8_LDB(dst, b, h) do { _Pragma("unroll") for (int n = 0; n < 2; ++n) _Pragma("unroll") for (int k = 0; k < 2; ++k) dst[n][k] = *(const LAS bf16x8*)(lds + PG8_SB(b, h) + boff + n * 2048 + k * 1024); } while (0)
#define PG8_MMA(ai, bj, At, Bt) do { __builtin_amdgcn_s_setprio(1); _Pragma("unroll") for (int m = 0; m < 4; ++m) _Pragma("unroll") for (int n = 0; n < 2; ++n) _Pragma("unroll") for (int k = 0; k < 2; ++k) \
        acc[ai][bj][m][n] = __builtin_amdgcn_mfma_f32_16x16x32_bf16(Bt[n][k], At[m][k], acc[ai][bj][m][n], 0, 0, 0); __builtin_amdgcn_s_setprio(0); } while (0)
#define PG8_WAIT_V(n) asm volatile("s_waitcnt vmcnt(" #n ")" ::: "memory")
#define PG8_WAIT_L(n) asm volatile("s_waitcnt lgkmcnt(" #n ")" ::: "memory")
#define PG8_BAR __builtin_amdgcn_s_barrier()
#define PG8_SCHED __builtin_amdgcn_sched_barrier(0)
    Unit cur, nxt; int ui = 0;
    if (!S.next(0, cur)) return;
    f32x4 acc[2][2][4][2];
#pragma unroll
    for (int a = 0; a < 2; ++a)
#pragma unroll
        for (int b = 0; b < 2; ++b)
#pragma unroll
            for (int m = 0; m < 4; ++m)
#pragma unroll
                for (int n = 0; n < 2; ++n) acc[a][b][m][n] = (f32x4){0.f, 0.f, 0.f, 0.f};
    bf16x8 At[4][2], B0[2][2], B1[2][2];
    const char* cA = S.pa(cur); const char* cB = S.pb(cur);
    {
        PG8_STAGE(PG8_SB(0, 0), cB, voffB); PG8_STAGE(PG8_SB(0, 1), cB + hsB, voffB); PG8_STAGE(PG8_SA(0, 0), cA, voffA); PG8_STAGE(PG8_SA(0, 1), cA + hsA, voffA);
        if (wr == 1) PG8_BAR;
        PG8_WAIT_V(2); PG8_BAR;
        PG8_STAGE(PG8_SB(1, 0), cB + kstep, voffB); PG8_STAGE(PG8_SA(1, 0), cA + kstep, voffA); PG8_STAGE(PG8_SB(1, 1), cB + hsB + kstep, voffB);
        PG8_WAIT_V(6); PG8_BAR;
    }
    for (;;) {
        const bool has_next = S.next(ui + 1, nxt);
        const char* nA = has_next ? S.pa(nxt) : cA; const char* nB = has_next ? S.pb(nxt) : cB;
        const int nt = S.nt(cur);
        for (int t = 0; t < nt; t += 2) {
            const bool last = (t == nt - 2);
            const char* a1 = cA + (size_t)(t + 1) * kstep;
            const char* a2 = last ? nA : cA + (size_t)(t + 2) * kstep; const char* b2 = last ? nB : cB + (size_t)(t + 2) * kstep;
            const char* a3 = a2 + kstep; const char* b3 = b2 + kstep;
            PG8_LDB(B0, 0, 0); PG8_LDB(B1, 0, 1); PG8_SCHED; PG8_LDA(At, 0, 0); PG8_STAGE(PG8_SA(1, 1), a1 + hsA, voffA);
            PG8_WAIT_V(8); PG8_WAIT_L(0); PG8_BAR; PG8_MMA(0, 0, At, B0); PG8_MMA(0, 1, At, B1); PG8_BAR; PG8_SCHED;
            PG8_LDA(At, 0, 1); PG8_STAGE(PG8_SB(0, 0), b2, voffB); PG8_STAGE(PG8_SB(0, 1), b2 + hsB, voffB); PG8_STAGE(PG8_SA(0, 0), a2, voffA);
            PG8_WAIT_V(8); PG8_WAIT_L(0); PG8_BAR; PG8_MMA(1, 0, At, B0); PG8_MMA(1, 1, At, B1); PG8_BAR; PG8_SCHED;
            PG8_LDB(B0, 1, 0); PG8_LDB(B1, 1, 1); PG8_SCHED; PG8_LDA(At, 1, 0); PG8_STAGE(PG8_SA(0, 1), a2 + hsA, voffA);
            PG8_WAIT_V(8); PG8_WAIT_L(0); PG8_BAR; PG8_MMA(0, 0, At, B0); PG8_MMA(0, 1, At, B1); PG8_BAR; PG8_SCHED;
            PG8_LDA(At, 1, 1); PG8_STAGE(PG8_SB(1, 0), b3, voffB); PG8_STAGE(PG8_SB(1, 1), b3 + hsB, voffB); PG8_STAGE(PG8_SA(1, 0), a3, voffA);
            PG8_WAIT_V(8); PG8_WAIT_L(0); PG8_BAR; PG8_MMA(1, 0, At, B0); PG8_MMA(1, 1, At, B1); PG8_BAR; PG8_SCHED;
        }
        if (wr == 0) PG8_BAR;
        E(acc, cur, wr, wc, fr, fq);
        if (!has_next) break;
#pragma unroll
        for (int a = 0; a < 2; ++a)
#pragma unroll
            for (int b = 0; b < 2; ++b)
#pragma unroll
                for (int m = 0; m < 4; ++m)
#pragma unroll
                    for (int n = 0; n < 2; ++n) acc[a][b][m][n] = (f32x4){0.f, 0.f, 0.f, 0.f};
        cur = nxt; cA = nA; cB = nB; ++ui;
        if (wr == 1) PG8_BAR;
    }
    PG8_WAIT_V(0);
    PG8_BAR;
#undef PG8_SA
#undef PG8_SB
#undef PG8_STAGE
#undef PG8_LDA
#undef PG8_LDB
#undef PG8_MMA
#undef PG8_WAIT_V
#undef PG8_WAIT_L
#undef PG8_BAR
#undef PG8_SCHED
}

struct EpiGLU {
    bf16_t* O; int ldc; int coff; const float* rowsq; int mode;
    __device__ __forceinline__ void operator()(const f32x4 (&acc)[2][2][4][2], const Unit& u, int wr, int wc, int fr, int fq) const {
        const int row0 = u.pm * BM + wr * 64 + fr, col0 = coff + u.pn * 128 + wc * 32 + 8 * fq;
#pragma unroll
        for (int ai = 0; ai < 2; ++ai)
#pragma unroll
            for (int m = 0; m < 4; ++m) {
                const int r = row0 + ai * HALF + m * 16;
                float rs = 1.f; if (mode == 0) rs = rsqrtf(rowsq[r] * (1.f / 1024.f) + EPS);
                f32x4 o[2];
#pragma unroll
                for (int n = 0; n < 2; ++n)
#pragma unroll
                    for (int j = 0; j < 4; ++j) { const float a = acc[ai][0][m][n][j] * rs, b = acc[ai][1][m][n][j] * rs;
                        o[n][j] = (mode == 0) ? a * b * sigmoidf_(a) : a * sigmoidf_(b); }
                *(u32x4*)(O + (size_t)r * ldc + col0) = pack8(o[0], o[1]);
            }
    }
};
struct EpiResid {
    const float* Hin; float* Hout; bf16_t* HBo; float* rsn; float scale;
    __device__ __forceinline__ void operator()(const f32x4 (&acc)[2][2][4][2], const Unit& u, int wr, int wc, int fr, int fq) const {
        const int row0 = u.pm * BM + wr * 64 + fr, col0 = u.pn * BM + wc * 32 + 8 * fq;
#pragma unroll
        for (int ai = 0; ai < 2; ++ai)
#pragma unroll
            for (int m = 0; m < 4; ++m) {
                const int r = row0 + ai * HALF + m * 16; float ss = 0.f;
#pragma unroll
                for (int bj = 0; bj < 2; ++bj) { const size_t off = (size_t)r * DM + col0 + bj * HALF;
                    f32x4 h0 = *(const f32x4*)(Hin + off), h1 = *(const f32x4*)(Hin + off + 4);
                    h0 = h0 + acc[ai][bj][m][0] * scale; h1 = h1 + acc[ai][bj][m][1] * scale;
                    *(f32x4*)(Hout + off) = h0; *(f32x4*)(Hout + off + 4) = h1;
                    if (HBo) *(u32x4*)(HBo + off) = pack8(h0, h1);
                    ss += h0[0] * h0[0] + h0[1] * h0[1] + h0[2] * h0[2] + h0[3] * h0[3] + h1[0] * h1[0] + h1[1] * h1[1] + h1[2] * h1[2] + h1[3] * h1[3]; }
                if (rsn) { ss += __shfl_xor(ss, 16); ss += __shfl_xor(ss, 32); if (fq == 0) atomicAdd(rsn + r, ss); }
                __builtin_amdgcn_sched_barrier(0);
            }
    }
};
struct EpiProj {
    bf16_t* O; int ldc; int ncols; const float* rowsq; int act;
    __device__ __forceinline__ void operator()(const f32x4 (&acc)[2][2][4][2], const Unit& u, int wr, int wc, int fr, int fq) const {
        const int row0 = u.pm * BM + wr * 64 + fr, col0 = u.pn * BM + wc * 32 + 8 * fq;
#pragma unroll
        for (int ai = 0; ai < 2; ++ai)
#pragma unroll
            for (int m = 0; m < 4; ++m) {
                const int r = row0 + ai * HALF + m * 16; const float rs = rsqrtf(rowsq[r] * (1.f / 1024.f) + EPS);
#pragma unroll
                for (int bj = 0; bj < 2; ++bj) { const int c = col0 + bj * HALF;
                    if (c < ncols) { f32x4 v0 = acc[ai][bj][m][0] * rs, v1 = acc[ai][bj][m][1] * rs;
                        if (act == 2) {
#pragma unroll
                            for (int j = 0; j < 4; ++j) { v0[j] = sigmoidf_(v0[j]); v1[j] = sigmoidf_(v1[j]); }
                            *((u32x4*)O + ((size_t)((u.pm * 16 + u.pn) * 16 + (ai * 4 + m) * 2 + bj)) * NTHR + threadIdx.x) = pack8(v0, v1); continue; }
                        if (act) {
#pragma unroll
                            for (int j = 0; j < 4; ++j) { v0[j] = sigmoidf_(v0[j]); v1[j] = sigmoidf_(v1[j]); } }
                        *(u32x4*)(O + (size_t)r * ldc + c) = pack8(v0, v1); } }
            }
    }
};
struct EpiPb {
    bf16_t* MX; const bf16_t* Gt; int n_;
    __device__ __forceinline__ void operator()(const f32x4 (&acc)[2][2][4][2], const Unit& u, int wr, int wc, int fr, int fq) const {
        int row0 = u.pm * BM + wr * 64 + fr, col0 = u.pn * BM + wc * 32 + 8 * fq; const int n = (n_ < 0) ? u.kind : n_;
        int tl = threadIdx.x; asm volatile("" : "+v"(tl), "+v"(row0));
#pragma unroll
        for (int ai = 0; ai < 2; ++ai)
#pragma unroll
            for (int m = 0; m < 4; ++m) {
                const int r = row0 + ai * HALF + m * 16;
#pragma unroll
                for (int bj = 0; bj < 2; ++bj) { const int c = col0 + bj * HALF;
                    float g[8]; unpack8(*((const u32x4*)Gt + ((size_t)((u.pm * 16 + n * 4 + u.pn) * 16 + (ai * 4 + m) * 2 + bj)) * NTHR + tl), g); f32x4 p0, p1;
#pragma unroll
                    for (int j = 0; j < 4; ++j) { p0[j] = g[j] * acc[ai][bj][m][0][j]; p1[j] = g[4 + j] * acc[ai][bj][m][1][j]; }
                    bf16_t* mp = MX + (size_t)r * DM + c;
                    if (n > 0) { float o[8]; unpack8(*(const u32x4*)mp, o);
#pragma unroll
                        for (int j = 0; j < 4; ++j) { p0[j] += o[j]; p1[j] += o[4 + j]; } }
                    *(u32x4*)mp = pack8(p0, p1); }
                __builtin_amdgcn_sched_barrier(0);
            }
    }
};
}

struct Args { const float* in[25]; float* out; unsigned char* ws; int ph_lo, ph_hi; };

__device__ __forceinline__ void tr_item(const float* W, int ldn, int col0, const float* gain, bf16_t* WT, int ldk, int koff, int halfn, int nblk, float* scr, int item, int lane) {
    const int kb = item / nblk, nb = item % nblk, k0 = 64 * kb, n0 = 64 * nb;
    const int n4 = (lane & 15) * 4, kq = lane >> 4;
    f32x4 v[16];
#pragma unroll
    for (int i = 0; i < 16; ++i) v[i] = *(const f32x4*)(W + (size_t)(k0 + 4 * i + kq) * ldn + col0 + n0 + n4);
#pragma unroll
    for (int i = 0; i < 16; ++i) { const int kk = 4 * i + kq; const float gv = gain ? gain[k0 + kk] : 1.f; float* d = scr + kk * 65 + n4;
        d[0] = v[i][0] * gv; d[1] = v[i][1] * gv; d[2] = v[i][2] * gv; d[3] = v[i][3] * gv; }
    LDS_WAIT();
    int rbase = n0;
    if (halfn) { const int half = n0 / halfn, ff = n0 % halfn; rbase = (ff / 128) * 256 + half * 128 + (ff % 128); }
    const int c = lane & 7;
#pragma unroll
    for (int j = 0; j < 8; ++j) { const int n = (lane >> 3) + 8 * j; const float* s = scr + (8 * c) * 65 + n;
        u32x4 o; o.x = cvt_pk_bf16(s[0 * 65], s[1 * 65]); o.y = cvt_pk_bf16(s[2 * 65], s[3 * 65]); o.z = cvt_pk_bf16(s[4 * 65], s[5 * 65]); o.w = cvt_pk_bf16(s[6 * 65], s[7 * 65]);
        *(u32x4*)(WT + (size_t)(rbase + n) * ldk + koff + k0 + 8 * c) = o; }
    LDS_WAIT();
}

__device__ __forceinline__ float wave_sum(float v) {
#pragma unroll
    for (int o = 1; o < 64; o <<= 1) v += __shfl_xor(v, o);
    return v;
}

__device__ __forceinline__ void phase_convert(const Args& a, int l, char* lds, int gw, int NGW, int lane, int wave) {
    unsigned char* ws = a.ws;
    float* scr = (float*)(lds + wave * 16640);
    const float* W1 = a.in[2] + (size_t)l * DM * 2 * FF; const float* W2 = a.in[3] + (size_t)l * FF * DM;
    const float* WIN = a.in[5] + (size_t)l * DM * IN_W;
    const float* WBR = a.in[20] + (size_t)l * 4 * 256 * DM; const float* WO = a.in[21] + (size_t)l * DM * DM;
    const float* W3 = a.in[23] + (size_t)l * DM * 2 * FF; const float* W4 = a.in[24] + (size_t)l * FF * DM;
    const float* WGLU = a.in[14] + (size_t)l * 256 * 512;
    const float* g1 = a.in[1] + l * DM; const float* gm = a.in[4] + l * DM; const float* g2 = a.in[22] + l * DM;
    constexpr int I1 = 16 * 88, I2 = 44 * 16, IP = 16 * 41, IG = 16 * 64, IB = 4 * 4 * 16, IO = 16 * 16, IGL = 4 * 8;
    int off = 0;
#define CONV_LOOP(I, CALL) { int g0 = gw - off; if (g0 < 0) g0 += NGW; for (int r = g0; r < (I); r += NGW) { CALL; } off = (off + (I)) % NGW; }
    CONV_LOOP(I1, tr_item(W1, 2 * FF, 0, g1, (bf16_t*)(ws + WS_W1T), DM, 0, FF, 88, scr, r, lane))
    CONV_LOOP(I2, tr_item(W2, DM, 0, nullptr, (bf16_t*)(ws + WS_W2T), FF, 0, 0, 16, scr, r, lane))
    CONV_LOOP(IP, tr_item(WIN, IN_W, 0, gm, (bf16_t*)(ws + WS_WPT), DM, 0, 0, 41, scr, r, lane))
    CONV_LOOP(IG, tr_item(WIN, IN_W, C_GATE, gm, (bf16_t*)(ws + WS_WGT), DM, 0, 0, 64, scr, r, lane))
    CONV_LOOP(IB, tr_item(WBR + (size_t)(r / 64) * 256 * DM, DM, 0, nullptr, (bf16_t*)(ws + WS_WBT), DM, (r / 64) * 256, 0, 16, scr, r % 64, lane))
    CONV_LOOP(IO, tr_item(WO, DM, 0, nullptr, (bf16_t*)(ws + WS_WOT), DM, 0, 0, 16, scr, r, lane))
    CONV_LOOP(I1, tr_item(W3, 2 * FF, 0, g2, (bf16_t*)(ws + WS_W3T), DM, 0, FF, 88, scr, r, lane))
    CONV_LOOP(I2, tr_item(W4, DM, 0, nullptr, (bf16_t*)(ws + WS_W4T), FF, 0, 0, 16, scr, r, lane))
    CONV_LOOP(IGL, tr_item(WGLU, 512, 0, nullptr, (bf16_t*)(ws + WS_WGLUT), 256, 0, 256, 8, scr, r, lane))
    { u32x4* z = (u32x4*)(ws + WS_WPT + (size_t)2624 * DM * 2); const int nz = 192 * DM * 2 / 16;
      for (int i = gw * 64 + lane; i < nz; i += NGW * 64) z[i] = (u32x4){0u, 0u, 0u, 0u}; }
    { const int gi = gw * 64 + lane;
      if (gi < 1024) { const int g = gi >> 6;
          const float lr = a.in[6][l * 1024 + gi], li = a.in[7][l * 1024 + gi]; const float dt = expf(a.in[8][l * 16 + g]);
          const float er = expf(lr * dt); float sn, cs; sincosf(li * dt, &sn, &cs);
          const float br = er * cs, bi = er * sn;
          const float nr = br - 1.f, ni = bi, den = lr * lr + li * li;
          const float fr = (nr * lr + ni * li) / den, fi = (ni * lr - nr * li) / den;
          f32x2* lamb = (f32x2*)(ws + WS_S5P); f32x2* lam64 = (f32x2*)(ws + WS_S5P + 8192);
          f32x2* bbar = (f32x2*)(ws + WS_S5P + 16384); float* ct = (float*)(ws + WS_S5P + 16384 + 131072);
          lamb[gi] = (f32x2){br, bi};
          float pr = br, pi = bi;
#pragma unroll
          for (int s = 0; s < 6; ++s) { const float tr = pr * pr - pi * pi, ti = 2.f * pr * pi; pr = tr; pi = ti; }
          lam64[gi] = (f32x2){pr, pi};
          const float* bre = a.in[9] + (size_t)l * 16384 + (size_t)gi * 16; const float* bim = a.in[10] + (size_t)l * 16384 + (size_t)gi * 16;
          for (int h = 0; h < 16; ++h) { const float xr = bre[h], xi = bim[h]; bbar[((gi >> 6) * 16 + h) * 64 + (gi & 63)] = (f32x2){fr * xr - fi * xi, fr * xi + fi * xr}; }
          const int p = gi & 63;
          const float* cre = a.in[11] + (size_t)l * 16384 + (size_t)g * 1024; const float* cim = a.in[12] + (size_t)l * 16384 + (size_t)g * 1024;
          for (int h = 0; h < 16; ++h) { ct[gi * 32 + h] = cre[h * 64 + p]; ct[gi * 32 + 16 + h] = cim[h * 64 + p]; }
      } }
    if (l == 0) {
        { float* rq = (float*)(ws + WS_ROWSQ); for (int i = gw * 64 + lane; i < 5 * T; i += NGW * 64) rq[T + i] = 0.f; }
        { float* cs = (float*)(ws + WS_ROPE); float* sn = cs + SEQ * 32;
          for (int i = gw * 64 + lane; i < SEQ * 32; i += NGW * 64) { const int pos = i >> 5, j = i & 31;
              const float inv = powf(10000.f, -(float)(2 * j) / 64.f); const float ang = (float)pos * inv; float s, c; sincosf(ang, &s, &c); cs[i] = c; sn[i] = s; } }
        { const float* x = a.in[0]; bf16_t* hb = (bf16_t*)(ws + WS_HB); float* rq = (float*)(ws + WS_ROWSQ);
          for (int m = gw; m < T; m += NGW) { const f32x4* xr = (const f32x4*)(x + (size_t)m * DM) + lane; float s = 0.f; f32x4 v[4];
#pragma unroll
              for (int j = 0; j < 4; ++j) { v[j] = xr[64 * j]; s += v[j][0] * v[j][0] + v[j][1] * v[j][1] + v[j][2] * v[j][2] + v[j][3] * v[j][3]; }
              s = wave_sum(s); if (lane == 0) rq[m] = s;
              u32x2* o = (u32x2*)(hb + (size_t)m * DM) + lane;
#pragma unroll
              for (int j = 0; j < 4; ++j) o[64 * j] = (u32x2){cvt_pk_bf16(v[j][0], v[j][1]), cvt_pk_bf16(v[j][2], v[j][3])}; } }
    }
}

__device__ __forceinline__ bf16x8 ldfrag(const char* base, int row, int pitch, int k0, int lane) {
    return *(const bf16x8*)(base + ((size_t)(row + (lane & 15)) * pitch + k0 + (lane >> 4) * 8) * 2);
}
#define MFMA16(a, b, c) __builtin_amdgcn_mfma_f32_16x16x32_bf16((a), (b), (c), 0, 0, 0)

__device__ __forceinline__ void dsa_rope_phase(const Args& a, int l, int gw, int NGW, int lane) {
    bf16_t* proj = (bf16_t*)(a.ws + WS_ACT); const float* cs = (const float*)(a.ws + WS_ROPE); const float* sn = cs + SEQ * 32;
    const float* qn = a.in[18] + l * 64; const float* kn = a.in[19] + l * 64;
    const int l32 = lane & 31, vec = l32 >> 2, j = l32 & 3;
    const float* gsrc = (vec < 4) ? qn : kn;
    float ga[8], gb[8];
#pragma unroll
    for (int e = 0; e < 8; ++e) { ga[e] = gsrc[8 * j + e]; gb[e] = gsrc[32 + 8 * j + e]; }
    const float osc = (vec < 4) ? 0.125f : 1.f;
    const int col = (vec < 4) ? (C_DQ + vec * 64) : (C_DK + (vec - 4) * 64);
    for (int pair = gw; pair < T / 2; pair += NGW) {
        const int tok = 2 * pair + (lane >> 5); const int pos = tok & (SEQ - 1);
        bf16_t* p = proj + (size_t)tok * PP + col + 8 * j;
        float x1[8], x2[8]; unpack8(*(const u32x4*)p, x1); unpack8(*(const u32x4*)(p + 32), x2);
        float ss = 0.f;
#pragma unroll
        for (int e = 0; e < 8; ++e) ss += x1[e] * x1[e] + x2[e] * x2[e];
        ss += __shfl_xor(ss, 1); ss += __shfl_xor(ss, 2);
        const float ri = rsqrtf(ss * (1.f / 64.f) + EPS);
        const f32x4* cp = (const f32x4*)(cs + pos * 32 + 8 * j); const f32x4* sp = (const f32x4*)(sn + pos * 32 + 8 * j);
        const f32x4 c0 = cp[0], c1 = cp[1], s0 = sp[0], s1 = sp[1];
        f32x4 o1[2], o2[2];
#pragma unroll
        for (int e = 0; e < 8; ++e) { const float c = (e < 4) ? c0[e & 3] : c1[e & 3], s = (e < 4) ? s0[e & 3] : s1[e & 3];
            const float y1 = x1[e] * ri * ga[e], y2 = x2[e] * ri * gb[e];
            o1[e >> 2][e & 3] = (y1 * c - y2 * s) * osc; o2[e >> 2][e & 3] = (y2 * c + y1 * s) * osc; }
        *(u32x4*)p = pack8(o1[0], o1[1]); *(u32x4*)(p + 32) = pack8(o2[0], o2[1]);
    }
}

__device__ __forceinline__ void s5_load_u(const bf16_t* proj, int b, int c, int g, float* U, int lane) {
    const bf16_t* p = proj + (size_t)(b * SEQ + c * 64 + lane) * PP + C_S5U + g * 16;
    float f[16]; unpack8(*(const u32x4*)p, f); unpack8(*(const u32x4*)(p + 8), f + 8);
    f32x4* d = (f32x4*)(U + lane * 16);
#pragma unroll
    for (int i = 0; i < 4; ++i) d[i] = (f32x4){f[4 * i], f[4 * i + 1], f[4 * i + 2], f[4 * i + 3]};
    LDS_WAIT();
}

__device__ __forceinline__ void s5_pre_phase(const Args& a, char* lds, int gw, int NGW, int lane, int wave) {
    const bf16_t* proj = (const bf16_t*)(a.ws + WS_ACT);
    const f32x2* lamb = (const f32x2*)(a.ws + WS_S5P); const f32x2* bbar = (const f32x2*)(a.ws + WS_S5P + 16384);
    f32x2* E = (f32x2*)(a.ws + WS_S5E);
    float* U = (float*)(lds + wave * 12544); f32x2* BU = (f32x2*)(lds + wave * 12544 + 4096);
    const int i16 = lane & 15, kq = lane >> 4;
    for (int item = gw; item < 4096; item += NGW) {
        const int g = item & 15, c = (item >> 4) & 127, b = item >> 11;
        s5_load_u(proj, b, c, g, U, lane);
        const f32x2 lam = lamb[g * 64 + lane];
        f32x2 ab[4][4];
#pragma unroll
        for (int pt = 0; pt < 4; ++pt)
#pragma unroll
            for (int s2 = 0; s2 < 4; ++s2) ab[pt][s2] = bbar[(g * 16 + 4 * kq + s2) * 64 + pt * 16 + i16];
        float sr = 0.f, si = 0.f;
        for (int tb = 0; tb < 4; ++tb) {
            const f32x4 uv = *(const f32x4*)(U + (tb * 16 + i16) * 16 + 4 * kq);
#pragma unroll
            for (int pt = 0; pt < 4; ++pt) { f32x4 dr = {0.f, 0.f, 0.f, 0.f}, di = {0.f, 0.f, 0.f, 0.f};
#pragma unroll
                for (int s2 = 0; s2 < 4; ++s2) { dr = __builtin_amdgcn_mfma_f32_16x16x4f32(ab[pt][s2][0], uv[s2], dr, 0, 0, 0); di = __builtin_amdgcn_mfma_f32_16x16x4f32(ab[pt][s2][1], uv[s2], di, 0, 0, 0); }
#pragma unroll
                for (int j = 0; j < 4; ++j) BU[i16 * 66 + pt * 16 + kq * 4 + j] = (f32x2){dr[j], di[j]}; }
            LDS_WAIT();
#pragma unroll 4
            for (int tt = 0; tt < 16; ++tt) { const f32x2 v = BU[tt * 66 + lane];
                const float nr = lam[0] * sr - lam[1] * si + v[0], ni = lam[0] * si + lam[1] * sr + v[1]; sr = nr; si = ni; }
            LDS_WAIT();
        }
        E[(size_t)((b * 128 + c) * 16 + g) * 64 + lane] = (f32x2){sr, si};
        LDS_WAIT();
    }
}

constexpr int GL_LA = 0, GL_QE = 8448, GL_KE = GL_QE + 5120, GL_KDT = GL_KE + 5120, GL_VT = GL_KDT + 4608, GL_ATT = GL_VT + 9216, GL_SINT = GL_ATT + 9216, GL_OF = GL_SINT + 5120, GL_END = GL_OF + 16640;
template <bool MAIN>
__device__ __forceinline__ void gla_item(const Args& a, int l, char* lds, int item, int tid, int lane, int wave) {
    const int c = item & 127, h = (item >> 7) & 3, b = item >> 9;
    const bf16_t* proj = (const bf16_t*)(a.ws + WS_ACT);
    float* LA = (float*)(lds + GL_LA); bf16_t* QE = (bf16_t*)(lds + GL_QE); bf16_t* KE = (bf16_t*)(lds + GL_KE); bf16_t* KDT = (bf16_t*)(lds + GL_KDT);
    bf16_t* VT = (bf16_t*)(lds + GL_VT); bf16_t* ATT = (bf16_t*)(lds + GL_ATT); bf16_t* SINT = (bf16_t*)(lds + GL_SINT); float* OF = (float*)(lds + GL_OF);
    const int t = tid >> 3, dg = tid & 7; const size_t tok = (size_t)b * SEQ + c * 64 + t;
    const bf16_t* prow = proj + tok * PP;
    const u32x4 ld_g0 = *(const u32x4*)(prow + C_GG), ld_g1 = *(const u32x4*)(prow + C_GG + 8);
    const u32x2 ld_q = *(const u32x2*)(prow + C_GQ + h * 32 + dg * 4), ld_k = *(const u32x2*)(prow + C_GK + h * 32 + dg * 4);
    const u32x4 ld_v = *(const u32x4*)(prow + C_GV + h * 64 + dg * 8);
    u32x4 ld_r = {0u, 0u, 0u, 0u}; f32x4 ld_s = {0.f, 0.f, 0.f, 0.f};
    if (MAIN) { ld_r = *(const u32x4*)(prow + C_GR + h * 64 + dg * 8);
        ld_s = *(const f32x4*)((const float*)(a.ws + WS_GSI) + (size_t)((b * 4 + h) * 128 + c) * 2048 + tid * 4); }
    { float g1[16]; unpack8(ld_g0, g1); unpack8(ld_g1, g1 + 8);
      const float* wg = a.in[15] + (size_t)l * 16 * 128 + h * 32 + dg * 4; const float* bg = a.in[16] + l * 128 + h * 32 + dg * 4;
      f32x4 z4 = *(const f32x4*)bg;
#pragma unroll
      for (int r = 0; r < 16; ++r) z4 = z4 + *(const f32x4*)(wg + r * 128) * g1[r];
#pragma unroll
      for (int dd = 0; dd < 4; ++dd) { const float z = z4[dd];
          const float ls = fminf(z, 0.f) - log1pf(__expf(-fabsf(z)));
          LA[t * 33 + dg * 4 + dd] = ls * (1.f / 16.f); } }
    __syncthreads();
#pragma unroll
    for (int dd = 0; dd < 4; ++dd) { const int d = wave * 4 + dd; float v = LA[lane * 33 + d];
#pragma unroll
        for (int o = 1; o < 64; o <<= 1) { const float y = __shfl_up(v, o); if (lane >= o) v += y; }
        LA[lane * 33 + d] = v; }
    __syncthreads();
    { float q4[4], k4[4];
      { const u32x2 qv = ld_q; const u32x2 kv = ld_k;
        q4[0] = bflo(qv.x); q4[1] = bfhi(qv.x); q4[2] = bflo(qv.y); q4[3] = bfhi(qv.y); k4[0] = bflo(kv.x); k4[1] = bfhi(kv.x); k4[2] = bflo(kv.y); k4[3] = bfhi(kv.y); }
#pragma unroll
      for (int dd = 0; dd < 4; ++dd) { const int d = dg * 4 + dd; const float bc = LA[t * 33 + d], bl = LA[63 * 33 + d];
          if (MAIN) { QE[t * 40 + d] = f2bf(q4[dd] * __expf(bc) * 0.17677669529663687f); KE[t * 40 + d] = f2bf(k4[dd] * __expf(-bc)); }
          else KDT[d * 72 + t] = f2bf(k4[dd] * __expf(bl - bc)); }
      float v8[8]; unpack8(ld_v, v8);
#pragma unroll
      for (int e = 0; e < 8; ++e) VT[(dg * 8 + e) * 72 + t] = f2bf(v8[e]);
      if (MAIN) { const f32x4 sv = ld_s; const int d = (tid * 4) >> 6, e0 = (tid * 4) & 63;
#pragma unroll
          for (int i = 0; i < 4; ++i) SINT[(e0 + i) * 40 + d] = f2bf(sv[i]); } }
    __syncthreads();
    if (!MAIN) {
        const int dt = wave >> 2, et = wave & 3; f32x4 acc = {0.f, 0.f, 0.f, 0.f};
#pragma unroll
        for (int ks = 0; ks < 2; ++ks) acc = MFMA16(ldfrag((const char*)KDT, dt * 16, 72, ks * 32, lane), ldfrag((const char*)VT, et * 16, 72, ks * 32, lane), acc);
        float* Sl = (float*)(a.ws + WS_GSL) + (size_t)((b * 4 + h) * 128 + c) * 2048;
#pragma unroll
        for (int j = 0; j < 4; ++j) Sl[(dt * 16 + (lane >> 4) * 4 + j) * 64 + et * 16 + (lane & 15)] = acc[j];
        if (tid < 32) ((float*)(a.ws + WS_GBL))[(size_t)((b * 4 + h) * 128 + c) * 32 + tid] = LA[63 * 33 + tid];
        __syncthreads();
        return;
    } else {
#pragma unroll
        for (int x = 0; x < 2; ++x) { const int id = wave * 2 + x, it = id >> 2, jt = id & 3; f32x4 acc = {0.f, 0.f, 0.f, 0.f};
            if (jt <= it) acc = MFMA16(ldfrag((const char*)QE, it * 16, 40, 0, lane), ldfrag((const char*)KE, jt * 16, 40, 0, lane), acc);
#pragma unroll
            for (int j = 0; j < 4; ++j) { const int i_ = it * 16 + (lane >> 4) * 4 + j, j_ = jt * 16 + (lane & 15); ATT[i_ * 72 + j_] = (j_ <= i_) ? f2bf(acc[j]) : (bf16_t)0; } }
        __syncthreads();
#pragma unroll
        for (int x = 0; x < 2; ++x) { const int id = wave * 2 + x, it = id >> 2, et = id & 3; f32x4 acc = {0.f, 0.f, 0.f, 0.f};
#pragma unroll
            for (int ks = 0; ks < 2; ++ks) acc = MFMA16(ldfrag((const char*)ATT, it * 16, 72, ks * 32, lane), ldfrag((const char*)VT, et * 16, 72, ks * 32, lane), acc);
            acc = MFMA16(ldfrag((const char*)QE, it * 16, 40, 0, lane), ldfrag((const char*)SINT, et * 16, 40, 0, lane), acc);
#pragma unroll
            for (int j = 0; j < 4; ++j) OF[(it * 16 + (lane >> 4) * 4 + j) * 65 + et * 16 + (lane & 15)] = acc[j]; }
        __syncthreads();
        { float o[8]; float ss = 0.f;
#pragma unroll
          for (int e = 0; e < 8; ++e) { o[e] = OF[t * 65 + dg * 8 + e]; ss += o[e] * o[e]; }
          ss += __shfl_xor(ss, 1); ss += __shfl_xor(ss, 2); ss += __shfl_xor(ss, 4);
          const float ri = rsqrtf(ss * (1.f / 64.f) + EPS);
          float r8[8]; unpack8(ld_r, r8);
          const float* gn = a.in[17] + l * 256 + h * 64 + dg * 8; f32x4 w0, w1;
#pragma unroll
          for (int e = 0; e < 8; ++e) { float v = o[e] * ri * gn[e] * (r8[e] * sigmoidf_(r8[e]));

              if (e < 4) w0[e] = v; else w1[e - 4] = v; }
          *(u32x4*)((bf16_t*)(a.ws + WS_BR) + tok * DM + 512 + h * 64 + dg * 8) = pack8(w0, w1); }
        __syncthreads();
    }
}

__device__ __forceinline__ void s5_scan(const Args& a, int ch) {
    const int b = ch >> 10, gp = ch & 1023;
    const f32x2 l64 = ((const f32x2*)(a.ws + WS_S5P + 8192))[gp];
    const f32x2* E = (const f32x2*)(a.ws + WS_S5E) + (size_t)b * 128 * 1024 + gp; f32x2* C = (f32x2*)(a.ws + WS_S5C) + (size_t)b * 128 * 1024 + gp;
    float cr = 0.f, ci = 0.f;
    for (int c0 = 0; c0 < 128; c0 += 16) { f32x2 e[16];
#pragma unroll
        for (int i = 0; i < 16; ++i) e[i] = E[(size_t)(c0 + i) * 1024];
#pragma unroll
        for (int i = 0; i < 16; ++i) { C[(size_t)(c0 + i) * 1024] = (f32x2){cr, ci}; const float nr = l64[0] * cr - l64[1] * ci + e[i][0], ni = l64[0] * ci + l64[1] * cr + e[i][1]; cr = nr; ci = ni; } }
}
__device__ __forceinline__ void gla_scan(const Args& a, int idx) {
    const int bh = idx >> 11, de = idx & 2047, d = de >> 6;
    const float* Sl = (const float*)(a.ws + WS_GSL) + (size_t)bh * 128 * 2048 + de; float* Si = (float*)(a.ws + WS_GSI) + (size_t)bh * 128 * 2048 + de;
    const float* bl = (const float*)(a.ws + WS_GBL) + (size_t)bh * 128 * 32 + d;
    float s = 0.f;
    for (int c0 = 0; c0 < 128; c0 += 16) { float x[16], g[16];
#pragma unroll
        for (int i = 0; i < 16; ++i) { x[i] = Sl[(size_t)(c0 + i) * 2048]; g[i] = bl[(c0 + i) * 32]; }
#pragma unroll
        for (int i = 0; i < 16; ++i) { Si[(size_t)(c0 + i) * 2048] = s; s = __expf(g[i]) * s + x[i]; } }
}

constexpr int AT_KS = 0, AT_VT = 9216, AT_BUF = 18432;
__device__ __forceinline__ void attn_load(const bf16_t* proj, size_t tokbase, int kcol, int vcol, int tid, u32x4& kv, u32x4& vv) {
    const int key = tid & 63, c8 = tid >> 6;
    const bf16_t* p = proj + (tokbase + key) * PP;
    kv = *(const u32x4*)(p + kcol + c8 * 8); vv = *(const u32x4*)(p + vcol + c8 * 8);
}
__device__ __forceinline__ void attn_store(char* lds, int tid, const u32x4& kv, const u32x4& vv) {
    const int key = tid & 63, c8 = tid >> 6;
    const int rho = ((key >> 2) & 3) * 16 + (key >> 4) * 4 + (key & 3);
    *(u32x4*)(lds + AT_KS + (rho * 72 + c8 * 8) * 2) = kv;
    bf16_t* VT = (bf16_t*)(lds + AT_VT);
    const unsigned w[4] = {vv.x, vv.y, vv.z, vv.w};
#pragma unroll
    for (int e = 0; e < 4; ++e) { VT[(c8 * 8 + 2 * e) * 72 + key] = (bf16_t)(w[e] & 0xffffu); VT[(c8 * 8 + 2 * e + 1) * 72 + key] = (bf16_t)(w[e] >> 16); }
}

__device__ __forceinline__ void sb_item(const Args& a, char* lds, int item, int tid, int lane, int wave) {
    const int qb = item & 63, h = (item >> 6) & 3, b = item >> 8; const int q0 = qb * 128;
    const bf16_t* proj = (const bf16_t*)(a.ws + WS_ACT);
    const int fr = lane & 15, fq = lane >> 4; const int qpos = q0 + wave * 16 + fr;
    bf16x8 qf[2];
    { const bf16_t* qp = proj + ((size_t)b * SEQ + qpos) * PP + C_SBQ + h * 64 + fq * 8; qf[0] = *(const bf16x8*)qp; qf[1] = *(const bf16x8*)(qp + 32); }
    f32x4 o[4];
#pragma unroll
    for (int i = 0; i < 4; ++i) o[i] = (f32x4){0.f, 0.f, 0.f, 0.f};
    float R = 1.f;
    u32x4 kvr, vvr; attn_load(proj, (size_t)b * SEQ + ((q0 >> 6) + 1) * 64, C_SBK + h * 64, C_SBV + h * 64, tid, kvr, vvr);
    attn_store(lds, tid, kvr, vvr);
    __syncthreads();
    attn_load(proj, (size_t)b * SEQ + (q0 >> 6) * 64, C_SBK + h * 64, C_SBV + h * 64, tid, kvr, vvr);
    int buf = 0;
    for (int jt = (q0 >> 6) + 1; jt >= 0; --jt) {
        char* L = lds + buf * AT_BUF;
        f32x4 s[4];
#pragma unroll
        for (int i = 0; i < 4; ++i) { s[i] = (f32x4){0.f, 0.f, 0.f, 0.f};
#pragma unroll
            for (int ks = 0; ks < 2; ++ks) s[i] = MFMA16(ldfrag(L + AT_KS, i * 16, 72, ks * 32, lane), qf[ks], s[i]); }
        const int kbase = jt * 64 + fq * 16;
        float w[16]; float suf = 1.f;
#pragma unroll
        for (int kk = 15; kk >= 0; --kk) { const float z = fminf(s[kk >> 2][kk & 3] * 0.125f, 80.f); const float e = __expf(z); float keep = __builtin_amdgcn_rcpf(1.f + e); float beta = e * keep;
            if (kbase + kk >= qpos) { keep = 1.f; beta = 0.f; }
            w[kk] = beta * suf; suf *= keep; }
        const float t1 = __shfl(suf, (lane + 16) & 63), t2 = __shfl(suf, (lane + 32) & 63), t3 = __shfl(suf, (lane + 48) & 63);
        float mult = R; if (fq < 3) mult *= t1; if (fq < 2) mult *= t2; if (fq < 1) mult *= t3;
        float tot = suf * __shfl_xor(suf, 16); tot *= __shfl_xor(tot, 32);
        R *= tot;
        bf16x8 pb[2];
#pragma unroll
        for (int s2 = 0; s2 < 2; ++s2) { u32x4 pk; pk.x = cvt_pk_bf16(w[s2 * 8 + 0] * mult, w[s2 * 8 + 1] * mult); pk.y = cvt_pk_bf16(w[s2 * 8 + 2] * mult, w[s2 * 8 + 3] * mult);
            pk.z = cvt_pk_bf16(w[s2 * 8 + 4] * mult, w[s2 * 8 + 5] * mult); pk.w = cvt_pk_bf16(w[s2 * 8 + 6] * mult, w[s2 * 8 + 7] * mult); pb[s2] = __builtin_bit_cast(bf16x8, pk); }
#pragma unroll
        for (int dt = 0; dt < 4; ++dt)
#pragma unroll
            for (int s2 = 0; s2 < 2; ++s2) { const bf16x8 vf = *(const bf16x8*)(L + AT_VT + ((dt * 16 + fr) * 72 + fq * 16 + s2 * 8) * 2); o[dt] = MFMA16(vf, pb[s2], o[dt]); }
        const int alive = !(R < 1e-35f);
        if (jt > 0) attn_store(lds + (buf ^ 1) * AT_BUF, tid, kvr, vvr);
        if (!__syncthreads_or(alive)) break;
        if (jt > 1) attn_load(proj, (size_t)b * SEQ + (jt - 2) * 64, C_SBK + h * 64, C_SBV + h * 64, tid, kvr, vvr);
        buf ^= 1;
    }
    bf16_t* op = (bf16_t*)(a.ws + WS_BR) + ((size_t)b * SEQ + qpos) * DM + 0 + h * 64 + fq * 4;
#pragma unroll
    for (int dt = 0; dt < 4; ++dt) *(u32x2*)(op + dt * 16) = (u32x2){cvt_pk_bf16(o[dt][0], o[dt][1]), cvt_pk_bf16(o[dt][2], o[dt][3])};
    __syncthreads();
}

__device__ __forceinline__ void dsa_item(const Args& a, int l, char* lds, int item, int tid, int lane, int wave) {
    const int qb = item & 63, h = (item >> 6) & 3, b = item >> 8; const int q0 = qb * 128;
    const bf16_t* proj = (const bf16_t*)(a.ws + WS_ACT);
    const int fr = lane & 15, fq = lane >> 4; const int qpos = q0 + wave * 16 + fr;
    float bound;
    { float gq = fabsf(a.in[18][l * 64 + lane]), gk = fabsf(a.in[19][l * 64 + lane]);
#pragma unroll
      for (int o = 1; o < 64; o <<= 1) { gq = fmaxf(gq, __shfl_xor(gq, o)); gk = fmaxf(gk, __shfl_xor(gk, o)); }
      bound = 8.f * gq * gk * 1.02f; }
    bf16x8 qf[2];
    { const bf16_t* qp = proj + ((size_t)b * SEQ + qpos) * PP + C_DQ + h * 64 + fq * 8; qf[0] = *(const bf16x8*)qp; qf[1] = *(const bf16x8*)(qp + 32); }
    f32x4 o[4];
#pragma unroll
    for (int i = 0; i < 4; ++i) o[i] = (f32x4){0.f, 0.f, 0.f, 0.f};
    float lsum = 0.f;
    int jlo = (q0 - 2048) >> 6; if (jlo < 0) jlo = 0;
    u32x4 kvr, vvr; attn_load(proj, (size_t)b * SEQ + ((q0 >> 6) + 1) * 64, C_DK + h * 64, C_DV + h * 64, tid, kvr, vvr);
    attn_store(lds, tid, kvr, vvr);
    __syncthreads();
    attn_load(proj, (size_t)b * SEQ + (q0 >> 6) * 64, C_DK + h * 64, C_DV + h * 64, tid, kvr, vvr);
    int buf = 0;
    for (int jt = (q0 >> 6) + 1; jt >= jlo; --jt) {
        char* L = lds + buf * AT_BUF;
        f32x4 s[4];
#pragma unroll
        for (int i = 0; i < 4; ++i) { s[i] = (f32x4){0.f, 0.f, 0.f, 0.f};
#pragma unroll
            for (int ks = 0; ks < 2; ++ks) s[i] = MFMA16(ldfrag(L + AT_KS, i * 16, 72, ks * 32, lane), qf[ks], s[i]); }
        const int d0 = qpos - (jt * 64 + fq * 16);
        const int dmin = (q0 + wave * 16) - (jt * 64 + 63);
        float w[16];
        if (dmin > 512) {
            const int ks_ = d0 & 15, ci = ks_ & 3, ii = ks_ >> 2; const int d = d0 - ks_;
            const f32x4 sv = (ii == 0) ? s[0] : (ii == 1) ? s[1] : (ii == 2) ? s[2] : s[3];
            const float val = (ci == 0) ? sv[0] : (ci == 1) ? sv[1] : (ci == 2) ? sv[2] : sv[3];
            const float p = (d >= 0 && d <= 2048) ? __expf(val - bound) : 0.f;
            lsum += p;
#pragma unroll
            for (int kk = 0; kk < 16; ++kk) w[kk] = (kk == ks_) ? p : 0.f;
        } else if (dmin > 128) {
            const int ci = d0 & 3;
#pragma unroll
            for (int i = 0; i < 4; ++i) { const float val = (ci == 0) ? s[i][0] : (ci == 1) ? s[i][1] : (ci == 2) ? s[i][2] : s[i][3];
                const int d = d0 - (4 * i + ci);
                const int m = ((d <= 512) ? 1 : 0) + ((d <= 2048 && (d & 15) == 0) ? 1 : 0) + ((d <= 128) ? 1 : 0);
                const float p = (d >= 0 && m > 0) ? (float)m * __expf(val - bound) : 0.f;
                lsum += p;
#pragma unroll
                for (int c = 0; c < 4; ++c) w[4 * i + c] = (c == ci) ? p : 0.f; }
        } else {
#pragma unroll
            for (int kk = 0; kk < 16; ++kk) { const int d = d0 - kk;
                const int m = (d <= 128 ? 1 : 0) + ((d <= 512 && (d & 3) == 0) ? 1 : 0) + ((d <= 2048 && (d & 15) == 0) ? 1 : 0);
                const float p = (d >= 0 && m > 0) ? (float)m * __expf(s[kk >> 2][kk & 3] - bound) : 0.f;
                w[kk] = p; lsum += p; }
        }
        bf16x8 pb[2];
#pragma unroll
        for (int s2 = 0; s2 < 2; ++s2) { u32x4 pk; pk.x = cvt_pk_bf16(w[s2 * 8 + 0], w[s2 * 8 + 1]); pk.y = cvt_pk_bf16(w[s2 * 8 + 2], w[s2 * 8 + 3]);
            pk.z = cvt_pk_bf16(w[s2 * 8 + 4], w[s2 * 8 + 5]); pk.w = cvt_pk_bf16(w[s2 * 8 + 6], w[s2 * 8 + 7]); pb[s2] = __builtin_bit_cast(bf16x8, pk); }
#pragma unroll
        for (int dt = 0; dt < 4; ++dt)
#pragma unroll
            for (int s2 = 0; s2 < 2; ++s2) { const bf16x8 vf = *(const bf16x8*)(L + AT_VT + ((dt * 16 + fr) * 72 + fq * 16 + s2 * 8) * 2); o[dt] = MFMA16(vf, pb[s2], o[dt]); }
        if (jt > jlo) attn_store(lds + (buf ^ 1) * AT_BUF, tid, kvr, vvr);
        __syncthreads();
        if (jt > jlo + 1) attn_load(proj, (size_t)b * SEQ + (jt - 2) * 64, C_DK + h * 64, C_DV + h * 64, tid, kvr, vvr);
        buf ^= 1;
    }
    lsum += __shfl_xor(lsum, 16); lsum += __shfl_xor(lsum, 32);
    const float inv = 1.f / lsum;
    bf16_t* op = (bf16_t*)(a.ws + WS_BR) + ((size_t)b * SEQ + qpos) * DM + 768 + h * 64 + fq * 4;
#pragma unroll
    for (int dt = 0; dt < 4; ++dt) *(u32x2*)(op + dt * 16) = (u32x2){cvt_pk_bf16(o[dt][0] * inv, o[dt][1] * inv), cvt_pk_bf16(o[dt][2] * inv, o[dt][3] * inv)};
}

__device__ __forceinline__ float gelu_tanh(float x) { const float u = 0.7978845608028654f * (x + 0.044715f * x * x * x); const float e = __expf(2.f * u); const float th = 1.f - 2.f * __builtin_amdgcn_rcpf(e + 1.f); return 0.5f * x * (1.f + th); }
__device__ __forceinline__ void s5_main_item(const Args& a, int l, char* lds, int item, int lane, int wave) {
    const int c = item & 127, b = item >> 7;
    const bf16_t* proj = (const bf16_t*)(a.ws + WS_ACT);
    const f32x2* lamb = (const f32x2*)(a.ws + WS_S5P); const f32x2* bbar = (const f32x2*)(a.ws + WS_S5P + 16384); const float* ct = (const float*)(a.ws + WS_S5P + 16384 + 131072);
    const f32x2* C = (const f32x2*)(a.ws + WS_S5C); bf16_t* Y = (bf16_t*)(a.ws + WS_YS5);
    float* U = (float*)(lds + wave * 12544); f32x2* ST = (f32x2*)(lds + wave * 12544 + 4096);
    for (int gi = 0; gi < 2; ++gi) { const int g = wave * 2 + gi;
        s5_load_u(proj, b, c, g, U, lane);
        const f32x2 lam = lamb[g * 64 + lane];
        const f32x2* abp = bbar + (size_t)(g * 16 + 4 * (lane >> 4)) * 64 + (lane & 15);
        const f32x2 c0 = C[(size_t)((b * 128 + c) * 16 + g) * 64 + lane];
        float sr = c0[0], si = c0[1];
        const int tt2 = lane & 15, hq = lane >> 4;
        const f32x4 dsk = *(const f32x4*)(a.in[13] + l * 256 + g * 16 + hq * 4);
        for (int tb = 0; tb < 4; ++tb) {
            { const f32x4 uvp = *(const f32x4*)(U + (tb * 16 + tt2) * 16 + 4 * hq);
#pragma unroll
              for (int pt = 0; pt < 4; ++pt) { f32x4 dr = {0.f, 0.f, 0.f, 0.f}, di = {0.f, 0.f, 0.f, 0.f};
#pragma unroll
                  for (int s2 = 0; s2 < 4; ++s2) { const f32x2 av = abp[s2 * 64 + pt * 16]; dr = __builtin_amdgcn_mfma_f32_16x16x4f32(av[0], uvp[s2], dr, 0, 0, 0); di = __builtin_amdgcn_mfma_f32_16x16x4f32(av[1], uvp[s2], di, 0, 0, 0); }
#pragma unroll
                  for (int j = 0; j < 4; ++j) ST[tt2 * 66 + pt * 16 + hq * 4 + j] = (f32x2){dr[j], di[j]}; } }
            LDS_WAIT();
#pragma unroll 4
            for (int tt = 0; tt < 16; ++tt) { const f32x2 v = ST[tt * 66 + lane];
                const float nr = lam[0] * sr - lam[1] * si + v[0], ni = lam[0] * si + lam[1] * sr + v[1]; sr = nr; si = ni;
                ST[tt * 66 + lane] = (f32x2){sr, si}; }
            LDS_WAIT();
            f32x4 y = {0.f, 0.f, 0.f, 0.f};
            { const f32x4* sp = (const f32x4*)((const float*)ST + tt2 * 132 + hq * 32);
#pragma unroll
              for (int q = 0; q < 8; ++q) { const f32x4 sv = sp[q];
                  const float* cp = ct + (size_t)(g * 64 + hq * 16 + 2 * q) * 32 + tt2;
                  const float c0 = cp[0], c1 = -cp[16], c2 = cp[32], c3 = -cp[48];
                  y = __builtin_amdgcn_mfma_f32_16x16x4f32(c0, sv[0], y, 0, 0, 0); y = __builtin_amdgcn_mfma_f32_16x16x4f32(c1, sv[1], y, 0, 0, 0);
                  y = __builtin_amdgcn_mfma_f32_16x16x4f32(c2, sv[2], y, 0, 0, 0); y = __builtin_amdgcn_mfma_f32_16x16x4f32(c3, sv[3], y, 0, 0, 0); } }
            const int t = tb * 16 + tt2; const f32x4 uv = *(const f32x4*)(U + t * 16 + hq * 4);
            y = y + dsk * uv;
            *(u32x2*)(Y + ((size_t)b * SEQ + c * 64 + t) * 256 + g * 16 + hq * 4) = (u32x2){cvt_pk_bf16(gelu_tanh(y[0]), gelu_tanh(y[1])), cvt_pk_bf16(gelu_tanh(y[2]), gelu_tanh(y[3]))};
            LDS_WAIT();
        }
    }
}

#define XB_TMO      128
#define XB_XCNT(j)  (256  + 64 * (j))
#define XB_XSUB(j)  (1280 + 64 * (j))
#define XB_XGEN(j)  (2304 + 64 * (j))
#define XB_TOP      3328
#define XB_TOPGEN   3392
#define XCD_BAR_WORDS 3456
#define XB_SPIN_CAP (1u << 18)
__device__ __forceinline__ unsigned xb_ld(unsigned* p)              { return __hip_atomic_load(p, __ATOMIC_RELAXED, __HIP_MEMORY_SCOPE_AGENT); }
__device__ __forceinline__ unsigned xb_add(unsigned* p, unsigned v) { return __hip_atomic_fetch_add(p, v, __ATOMIC_RELAXED, __HIP_MEMORY_SCOPE_AGENT); }
__device__ __forceinline__ unsigned xb_xcc_id() { return (unsigned)__builtin_amdgcn_s_getreg((3 << 11) | 20) & 0xFu; }
#define XB_SPIN(cond, bar) do { unsigned _sp = 0; while (cond) { __builtin_amdgcn_s_sleep(1); \
    if ((++_sp & 255u) == 0u) { if (xb_ld(&(bar)[XB_TMO])) break; if (_sp > XB_SPIN_CAP) { atomicAdd(&(bar)[XB_TMO], 1u); break; } } } } while (0)
__device__ __forceinline__ void xcd_barrier_complete(unsigned* bar, unsigned x, unsigned& nloc, unsigned& nx) {
    const unsigned G = gridDim.x * gridDim.y * gridDim.z;
    unsigned sum, cnt, mine, sp = 0u;
    for (;;) {
        sum = 0u; cnt = 0u; mine = 0u;
#pragma unroll
        for (unsigned j = 0; j < 16; ++j) { const unsigned c = xb_ld(&bar[XB_XCNT(j)]); sum += c; cnt += (c > 0u) ? 1u : 0u; mine = (j == x) ? c : mine; }
        if (sum == G) break;
        __builtin_amdgcn_s_sleep(1);
        if ((++sp & 255u) == 0u) { if (xb_ld(&bar[XB_TMO])) break; if (sp > XB_SPIN_CAP) { atomicAdd(&bar[XB_TMO], 1u); break; } }
    }
    nloc = mine > 0u ? mine : 1u; nx = cnt > 0u ? cnt : 1u;
}
__device__ __forceinline__ void xcd_barrier(unsigned* bar, volatile LAS unsigned* st) {
    asm volatile("s_waitcnt vmcnt(0)" ::: "memory");
    __syncthreads();
    if (threadIdx.x == 0) {
        const unsigned x = xb_xcc_id();
        __builtin_amdgcn_s_waitcnt(0);
        unsigned nloc = st[0], nx = st[1];
        if (nloc == 0u) { xcd_barrier_complete(bar, x, nloc, nx); st[0] = nloc; st[1] = nx; }
        const unsigned old = xb_add(&bar[XB_XSUB(x)], 1u);
        const unsigned gen = old / nloc;
        if (old + 1u == (gen + 1u) * nloc) {
            __builtin_amdgcn_fence(__ATOMIC_RELEASE, "agent");
            asm volatile("s_waitcnt vmcnt(0)" ::: "memory");
            const unsigned og = xb_add(&bar[XB_TOP], 1u);
            const unsigned tg = og / nx;
            if (og + 1u == (tg + 1u) * nx) xb_add(&bar[XB_TOPGEN], 1u);
            else XB_SPIN(xb_ld(&bar[XB_TOPGEN]) == tg, bar);
            __builtin_amdgcn_fence(__ATOMIC_ACQUIRE, "agent");
            xb_add(&bar[XB_XGEN(x)], 1u);
            asm volatile("s_waitcnt vmcnt(0)" ::: "memory");
        } else {
            XB_SPIN(xb_ld(&bar[XB_XGEN(x)]) == gen, bar);
            __builtin_amdgcn_fence(__ATOMIC_ACQUIRE, "agent");
            asm volatile("s_waitcnt vmcnt(0)" ::: "memory");
        }
    }
    __syncthreads();
}
constexpr int LDS_BARST = LDS_BYTES - 64;

enum { PH_CONV = 0, PH_FFN1A, PH_FFN1B, PH_PROJ, PH_MIXPRE, PH_MIXA, PH_MIXB, PH_GLU, PH_GATE, PH_PB0, PH_WOUT, PH_FFN2A, PH_FFN2B, PH_PER_LAYER };
constexpr int N_PHASES = 2 * PH_PER_LAYER;

#ifndef ENMASK
#define ENMASK 0xFFFFF
#endif
typedef const __attribute__((address_space(4))) Args* KArgP;
__device__ __forceinline__ Args load_args() {
#if defined(__HIP_DEVICE_COMPILE__)
    KArgP p = (KArgP)__builtin_amdgcn_kernarg_segment_ptr(); asm volatile("" : "+s"(p)); Args r;
#pragma unroll
    for (int i = 0; i < 25; ++i) r.in[i] = p->in[i];
    r.out = p->out; r.ws = p->ws; r.ph_lo = p->ph_lo; r.ph_hi = p->ph_hi; return r;
#else
    return Args{};
#endif
}
#ifndef DUPMASK
#define DUPMASK 0
#endif
#define REP(k) for (int rep_ = 0; rep_ < 1 + ((DUPMASK >> (k)) & 1); ++rep_)
#define RUN(k) (((ENMASK >> (k)) & 1) && lo <= l * PH_PER_LAYER + (k) && l * PH_PER_LAYER + (k) < hi)
#define SEAM(k) do { if (l * PH_PER_LAYER + (k) + 1 < hi) xcd_barrier((unsigned*)(load_args().ws + WS_BARW), (volatile LAS unsigned*)(ldsl + LDS_BARST)); } while (0)
template <int l>
__device__ __forceinline__ void layer_body(int lo, int hi, cg::grid_group& grid, LAS unsigned char* ldsl, char* lds) {
    const int tid = threadIdx.x, lane = tid & 63, wave = __builtin_amdgcn_readfirstlane(tid >> 6);
    const int G = gridDim.x, bx = blockIdx.x; const int gw = bx * NWAVES + wave, NGW = G * NWAVES;
#define PH_LOCALS const Args a = load_args(); unsigned char* ws = a.ws; float* rowsq = (float*)(ws + WS_ROWSQ); \
    bf16_t* HB = (bf16_t*)(ws + WS_HB); bf16_t* ACT = (bf16_t*)(ws + WS_ACT); bf16_t* BR = (bf16_t*)(ws + WS_BR); bf16_t* MX = (bf16_t*)(ws + WS_MIX); \
    (void)rowsq; (void)HB; (void)ACT; (void)BR; (void)MX;
        if (RUN(PH_CONV)) REP(PH_CONV) { PH_LOCALS phase_convert(a, l, lds, gw, NGW, lane, wave); SEAM(PH_CONV); }
        if (RUN(PH_FFN1A)) REP(PH_FFN1A) { PH_LOCALS
            pg8::StdSched S; S.init(HB, ws + WS_W1T, T, 2 * FF, DM, DM, DM, G, bx);
            pg8::EpiGLU E{ACT, FF, 0, rowsq + (size_t)(l * 3 + 0) * T, 0};
            pg8::gemm_phase(ldsl, DM, DM, S, E); SEAM(PH_FFN1A); }
        if (RUN(PH_FFN1B)) REP(PH_FFN1B) { PH_LOCALS
            pg8::StdSched S; S.init(ACT, ws + WS_W2T, T, DM, FF, FF, FF, G, bx);
            pg8::EpiResid E{l == 0 ? a.in[0] : a.out, a.out, HB, rowsq + (size_t)(l * 3 + 1) * T, 0.5f};
            pg8::gemm_phase(ldsl, FF, FF, S, E); SEAM(PH_FFN1B); }
        if (RUN(PH_PROJ)) REP(PH_PROJ) { PH_LOCALS
            pg8::StdSched S; S.init(HB, ws + WS_WPT, T, PP, DM, DM, DM, G, bx);
            pg8::EpiProj E{ACT, PP, C_GATE, rowsq + (size_t)(l * 3 + 1) * T, 0};
            pg8::gemm_phase(ldsl, DM, DM, S, E); SEAM(PH_PROJ); }
        if (RUN(PH_MIXPRE)) REP(PH_MIXPRE) { PH_LOCALS
#ifndef NO_S5
            dsa_rope_phase(a, l, gw, NGW, lane);
            s5_pre_phase(a, lds, gw, NGW, lane, wave);
#endif
            __syncthreads();
            for (int it = bx; it < 1024; it += G) gla_item<false>(a, l, lds, it, tid, lane, wave);
            SEAM(PH_MIXPRE); }
        if (RUN(PH_MIXA)) { PH_LOCALS
            unsigned* qctr = (unsigned*)(ws + WS_BARW) + XCD_BAR_WORDS + l; volatile LAS unsigned* qslot = (volatile LAS unsigned*)(ldsl + LDS_BARST + 16);
            if (bx < 4) s5_scan(a, bx * NTHR + tid);
            else if (bx < 36) gla_scan(a, (bx - 4) * NTHR + tid);
            for (;;) {
                if (tid == 0) *qslot = xb_add(qctr, 1u);
                __syncthreads();
                const int it = __builtin_amdgcn_readfirstlane((int)*qslot);
                __syncthreads();
                if (it >= 1024) break;
                if (it < 512) dsa_item(a, l, lds, ((it & 7) << 6) | (63 - (it >> 3)), tid, lane, wave);
                else sb_item(a, lds, it - 512, tid, lane, wave);
            }
            SEAM(PH_MIXA); }
        if (RUN(PH_MIXB)) REP(PH_MIXB) { PH_LOCALS
            for (int it = bx; it < 1280; it += G) { if (it < 256) {
#ifndef NO_S5
                s5_main_item(a, l, lds, it, lane, wave); __syncthreads();
#endif
            } else gla_item<true>(a, l, lds, it - 256, tid, lane, wave); }
            SEAM(PH_MIXB); }
        if (RUN(PH_GLU)) REP(PH_GLU) { PH_LOCALS
            pg8::StdSched S; S.init(ws + WS_YS5, ws + WS_WGLUT, T, 512, 256, 256, 256, G, bx);
            pg8::EpiGLU E{BR, DM, 256, nullptr, 1};
            pg8::gemm_phase(ldsl, 256, 256, S, E); SEAM(PH_GLU); }
        if (RUN(PH_GATE)) REP(PH_GATE) { PH_LOCALS
            pg8::StdSched S; S.init(HB, ws + WS_WGT, T, 4096, DM, DM, DM, G, bx);
            pg8::EpiProj E{(bf16_t*)(ws + WS_G), 4096, 4096, rowsq + (size_t)(l * 3 + 1) * T, 2};
            pg8::gemm_phase(ldsl, DM, DM, S, E); SEAM(PH_GATE); }
        if (RUN(PH_PB0)) { PH_LOCALS
            pg8::PbSched S; S.init(BR, ws + WS_WBT, G, bx);
            pg8::EpiPb E{MX, (const bf16_t*)(ws + WS_G), -1};
            pg8::gemm_phase(ldsl, DM, DM, S, E); SEAM(PH_PB0); }
        if (RUN(PH_WOUT)) REP(PH_WOUT) { PH_LOCALS
            pg8::StdSched S; S.init(MX, ws + WS_WOT, T, DM, DM, DM, DM, G, bx);
            pg8::EpiResid E{a.out, a.out, (bf16_t*)(ws + WS_HB2), rowsq + (size_t)(l * 3 + 2) * T, 1.0f};
            pg8::gemm_phase(ldsl, DM, DM, S, E); SEAM(PH_WOUT); }
        if (RUN(PH_FFN2A)) REP(PH_FFN2A) { PH_LOCALS
            pg8::StdSched S; S.init(ws + WS_HB2, ws + WS_W3T, T, 2 * FF, DM, DM, DM, G, bx);
            pg8::EpiGLU E{ACT, FF, 0, rowsq + (size_t)(l * 3 + 2) * T, 0};
            pg8::gemm_phase(ldsl, DM, DM, S, E); SEAM(PH_FFN2A); }
        if (RUN(PH_FFN2B)) REP(PH_FFN2B) { PH_LOCALS
            pg8::StdSched S; S.init(ACT, ws + WS_W4T, T, DM, FF, FF, FF, G, bx);
            pg8::EpiResid E{a.out, a.out, l == 0 ? HB : nullptr, l == 0 ? rowsq + (size_t)3 * T : nullptr, 0.5f};
            pg8::gemm_phase(ldsl, FF, FF, S, E); SEAM(PH_FFN2B); }
}

__global__ void __launch_bounds__(NTHR, 2) mega(Args a) {
    extern __shared__ __attribute__((aligned(16))) unsigned char lds_raw[];
    LAS unsigned char* ldsl = (LAS unsigned char*)lds_raw; char* lds = (char*)lds_raw;
    cg::grid_group grid = cg::this_grid();
    const int lo = a.ph_lo, hi = a.ph_hi;
    if (lo < 0) grid.sync();
    if (threadIdx.x == 0) { volatile LAS unsigned* st = (volatile LAS unsigned*)(ldsl + LDS_BARST); st[0] = 0u; st[1] = 0u;
        (void)xb_add(&((unsigned*)(a.ws + WS_BARW))[XB_XCNT(xb_xcc_id())], 1u); }
    __syncthreads();
    layer_body<0>(lo, hi, grid, ldsl, lds);
    layer_body<1>(lo, hi, grid, ldsl, lds);
}

extern "C" void kernel_launch(void* const* d_in, const int* in_sizes, int n_in, void* d_out, int out_size, void* d_ws, size_t ws_size, hipStream_t stream) {
    static int grid = 0;
    if (grid == 0) {
        if (n_in != 25 || in_sizes[0] != T * DM || out_size != T * DM || ws_size < WS_END) { fprintf(stderr, "kernel_launch: unexpected shapes (n_in %d, in0 %d, out %d, ws %zu < %zu)\n", n_in, n_in > 0 ? in_sizes[0] : -1, out_size, ws_size, (size_t)WS_END); grid = -1; return; }
        int dev = 0, cus = 0, per_cu = 0;
        (void)hipGetDevice(&dev); (void)hipDeviceGetAttribute(&cus, hipDeviceAttributeMultiprocessorCount, dev);
        if (hipFuncSetAttribute((const void*)mega, hipFuncAttributeMaxDynamicSharedMemorySize, LDS_BYTES) != hipSuccess) { fprintf(stderr, "kernel_launch: hipFuncSetAttribute failed\n"); grid = -1; return; }
        if (hipOccupancyMaxActiveBlocksPerMultiprocessor(&per_cu, (const void*)mega, NTHR, LDS_BYTES) != hipSuccess || per_cu < 1) { fprintf(stderr, "kernel_launch: occupancy query says %d\n", per_cu); per_cu = 1; }
        (void)hipGetLastError();
        grid = cus * per_cu;
    }
    if (grid < 0) return;
    Args a{};
    for (int i = 0; i < 25; ++i) a.in[i] = (const float*)d_in[i];
    a.out = (float*)d_out; a.ws = (unsigned char*)d_ws; a.ph_lo = 0; a.ph_hi = N_PHASES;
#if defined(MK_PER_PHASE)
    for (int ph = 0; ph < N_PHASES; ++ph) { a.ph_lo = ph; a.ph_hi = ph + 1; hipLaunchKernelGGL(mega, dim3(grid), dim3(NTHR), LDS_BYTES, stream, a); }
    hipError_t e = hipPeekAtLastError();
#else
    (void)hipMemsetAsync((char*)d_ws + WS_BARW, 0, (XCD_BAR_WORDS + 64) * 4, stream);
    void* args[] = {&a};
    hipError_t e = hipLaunchCooperativeKernel((const void*)mega, dim3(grid), dim3(NTHR), args, LDS_BYTES, stream);
#endif
    if (e != hipSuccess) fprintf(stderr, "kernel_launch: cooperative launch failed: %s (grid %d)\n", hipGetErrorString(e), grid);
}
```
